# Optimizing an MI355X kernel written in HIP

```python
import jax, jax.numpy as jnp
from jax import lax
import numpy as np

D_MODEL = 1024
BATCH = 8
SEQ = 2048
DEPTH = 4

HEAD_DIM = 64
CONV_WIDTH = 3 * D_MODEL // 8
POOL_WIDTH = D_MODEL // 4
SGU_WIDTH = D_MODEL - CONV_WIDTH - POOL_WIDTH
CONV_HEADS = CONV_WIDTH // HEAD_DIM
SGU_HEADS = SGU_WIDTH // HEAD_DIM
POOL_WINDOWS = (2, 4, 8, 16)
POOL_GROUPS = len(POOL_WINDOWS)
POOL_GROUP_DIM = POOL_WIDTH // POOL_GROUPS
CONV_K = 3
CHUNK = 128
MIX_WIDTH = CONV_WIDTH + POOL_WIDTH + SGU_WIDTH
IN_WIDTH = 3 * CONV_WIDTH + POOL_WIDTH + 2 * SGU_WIDTH
D_FF = -(-8 * D_MODEL // (3 * 256)) * 256
ALPHA = float((2 * DEPTH) ** 0.25)
BETA = float((8 * DEPTH) ** -0.25)
LN_EPS = 1e-5

kernel_name = "hybrid_conv_pool_sgu_deepnorm"


def _norm_stats(x, eps=LN_EPS):
    xf = x.astype(jnp.float32)
    mu = jnp.mean(xf, axis=-1, keepdims=True)
    var = jnp.mean(jnp.square(xf - mu), axis=-1, keepdims=True)
    return ((xf - mu) * lax.rsqrt(var + eps)).astype(x.dtype)


def layer_norm(x, g, b):
    return _norm_stats(x) * g + b


def short_gated_conv(xa, gb, gc, w_conv):
    z = gc * xa
    s = z.shape[1]
    zp = jnp.pad(z, ((0, 0), (CONV_K - 1, 0), (0, 0)))
    y = w_conv[0] * zp[:, 0:s] + w_conv[1] * zp[:, 1:s + 1] + w_conv[2] * zp[:, 2:s + 2]
    return gb * y


def multiscale_pool(p, w_pool, pool_scale):
    b, s, _ = p.shape
    pg = p.reshape(b, s, POOL_GROUPS, POOL_GROUP_DIM)
    cs = jnp.cumsum(pg.astype(jnp.float32), axis=1)
    t1 = jnp.arange(1, s + 1, dtype=jnp.float32)
    means = []
    for g, w in enumerate(POOL_WINDOWS):
        csg = cs[:, :, g]
        csp = jnp.pad(csg, ((0, 0), (w, 0), (0, 0)))
        win_sum = csp[:, w:] - csp[:, :s]
        count = jnp.minimum(t1, float(w))[None, :, None]
        means.append(win_sum / count)
    mean = jnp.stack(means, axis=2).astype(p.dtype)
    d = mean - pg
    y = jnp.einsum('bsgc,gcd->bsgd', d, w_pool)
    return y.reshape(b, s, POOL_WIDTH) * pool_scale


def chunked_sgu(uv, sgu_ln_g, w_spatial, b_spatial):
    b, s, _ = uv.shape
    uv = jax.nn.gelu(uv, approximate=False)
    u, v = uv[..., :SGU_WIDTH], uv[..., SGU_WIDTH:]
    vh = v.reshape(b, s, SGU_HEADS, HEAD_DIM)
    vh = _norm_stats(vh) * sgu_ln_g.reshape(SGU_HEADS, HEAD_DIM)
    vc = vh.reshape(b, s // CHUNK, CHUNK, SGU_HEADS, HEAD_DIM)
    mask = jnp.tril(jnp.ones((CHUNK, CHUNK), dtype=w_spatial.dtype))
    wm = w_spatial * mask
    mixed = jnp.einsum('hts,bnshd->bnthd', wm, vc) + b_spatial.T[None, None, :, :, None]
    return u * mixed.reshape(b, s, SGU_WIDTH)


def swiglu(h, w_gate_up, w_down):
    gu = h @ w_gate_up
    g, u = gu[..., :D_FF], gu[..., D_FF:]
    return (jax.nn.silu(g) * u) @ w_down


def setup_inputs(seed: int = 0) -> dict:
    key = jax.random.key(seed)
    ks = jax.random.split(key, 16)
    f32 = jnp.float32
    nrm = lambda k, shape: jax.random.normal(k, shape, dtype=f32)
    x = nrm(ks[0], (BATCH, SEQ, D_MODEL))
    w_in = nrm(ks[1], (DEPTH, D_MODEL, IN_WIDTH)) * D_MODEL ** -0.5
    w_conv = nrm(ks[2], (DEPTH, CONV_K, CONV_WIDTH)) * CONV_K ** -0.5
    w_pool = nrm(ks[3], (DEPTH, POOL_GROUPS, POOL_GROUP_DIM, POOL_GROUP_DIM)) * POOL_GROUP_DIM ** -0.5
    pool_scale = 1.0 + 0.1 * nrm(ks[4], (DEPTH, POOL_WIDTH))
    sgu_ln_g = 1.0 + 0.1 * nrm(ks[5], (DEPTH, SGU_WIDTH))
    w_spatial = nrm(ks[6], (DEPTH, SGU_HEADS, CHUNK, CHUNK)) * CHUNK ** -0.5
    b_spatial = 1.0 + 0.1 * nrm(ks[7], (DEPTH, SGU_HEADS, CHUNK))
    w_o = nrm(ks[8], (DEPTH, MIX_WIDTH, D_MODEL)) * (MIX_WIDTH ** -0.5) * BETA
    ln1_g = 1.0 + 0.1 * nrm(ks[9], (DEPTH, D_MODEL))
    ln1_b = 0.02 * nrm(ks[10], (DEPTH, D_MODEL))
    w_gate_up = nrm(ks[11], (DEPTH, D_MODEL, 2 * D_FF)) * D_MODEL ** -0.5
    w_down = nrm(ks[12], (DEPTH, D_FF, D_MODEL)) * (D_FF ** -0.5) * BETA
    ln2_g = 1.0 + 0.1 * nrm(ks[13], (DEPTH, D_MODEL))
    ln2_b = 0.02 * nrm(ks[14], (DEPTH, D_MODEL))
    return {"x": x, "w_in": w_in, "w_conv": w_conv, "w_pool": w_pool,
            "pool_scale": pool_scale, "sgu_ln_g": sgu_ln_g, "w_spatial": w_spatial,
            "b_spatial": b_spatial, "w_o": w_o, "ln1_g": ln1_g, "ln1_b": ln1_b,
            "w_gate_up": w_gate_up, "w_down": w_down, "ln2_g": ln2_g, "ln2_b": ln2_b}


def reference(x, w_in, w_conv, w_pool, pool_scale, sgu_ln_g, w_spatial, b_spatial,
              w_o, ln1_g, ln1_b, w_gate_up, w_down, ln2_g, ln2_b):
    c0 = CONV_WIDTH
    for l in range(DEPTH):
        proj = x @ w_in[l]
        xa = proj[..., 0:c0]
        gb = proj[..., c0:2 * c0]
        gc = proj[..., 2 * c0:3 * c0]
        p = proj[..., 3 * c0:3 * c0 + POOL_WIDTH]
        uv = proj[..., 3 * c0 + POOL_WIDTH:]
        ya = short_gated_conv(xa, gb, gc, w_conv[l])
        yb = multiscale_pool(p, w_pool[l], pool_scale[l])
        yc = chunked_sgu(uv, sgu_ln_g[l], w_spatial[l], b_spatial[l])
        mix = jnp.concatenate([ya, yb, yc], axis=-1) @ w_o[l]
        h = layer_norm(ALPHA * x + mix, ln1_g[l], ln1_b[l])
        x = layer_norm(ALPHA * h + swiglu(h, w_gate_up[l], w_down[l]), ln2_g[l], ln2_b[l])
    return x
```

```cpp
#include <hip/hip_runtime.h>
#include <hip/hip_cooperative_groups.h>
#include <cstdio>
#include <cstdint>
namespace pg8 {
#define PG8_LAS __attribute__((address_space(3)))
typedef unsigned short bf16_t;
typedef short bf16x8 __attribute__((ext_vector_type(8)));
typedef float f32x4 __attribute__((ext_vector_type(4)));
typedef unsigned u32x4 __attribute__((ext_vector_type(4)));
constexpr int BM = 256, BK = 64, HALF = 128, HTB = HALF * BK * 2  , STAGE_BYTES = 8 * HTB, NXCD = 8, WGM = 8;

__host__ __device__ __forceinline__ int lds_byte(int r, int c) { const int st = (r >> 4) * 2 + (c >> 5), rr = r & 15, cc = c & 31, ob = rr * 64 + cc * 2; return st * 1024 + (ob ^ (((ob >> 9) & 1) << 5)); }
__host__ __device__ __forceinline__ void stage_rc(int b, int& R, int& C) { const int st = b / 1024, sb = b % 1024, swz = sb ^ (((sb >> 9) & 1) << 5); R = (st >> 1) * 16 + swz / 64; C = (st & 1) * 32 + (swz % 64) / 2; }
__host__ __device__ __forceinline__ int perm32(int rho) { const int n = rho >> 4, i = rho & 15; return 8 * (i >> 2) + 4 * n + (i & 3); }

struct Unit { int pm, pn; };
struct Gemm { const bf16_t* A; const bf16_t* Bt; int M, N, K; };

struct StaticOrder {
    int nM, nN, nwg, G, c;
    __host__ __device__ void init(int M, int N, int G_, int c_) { nM = M / BM; nN = N / BM; nwg = nM * nN; G = G_; c = c_; }
    __host__ __device__ bool next(int i, Unit& u) const {
        const long L = (long)i * G + c; if (L >= nwg) return false;
        int wgid = (int)L; { const int q = nwg / NXCD, r = nwg % NXCD, xcd = wgid % NXCD, off = wgid / NXCD; wgid = (xcd < r ? xcd * (q + 1) : r * (q + 1) + (xcd - r) * q) + off; }
        const int nig = WGM * nN, gid = wgid / nig, fm = gid * WGM, gsz = (nM - fm) < WGM ? (nM - fm) : WGM;
        u.pm = fm + ((wgid % nig) % gsz); u.pn = (wgid % nig) / gsz; return true;
    }
    __device__ __forceinline__ void a_ready(const Unit&) const {}
    __device__ __forceinline__ void done(const Unit&) const {}
};

__device__ __forceinline__ unsigned cvt_pk_bf16(float lo, float hi) { unsigned r; asm volatile("v_cvt_pk_bf16_f32 %0, %1, %2" : "=v"(r) : "v"(lo), "v"(hi)); return r; }
typedef float f32x2 __attribute__((ext_vector_type(2)));
__device__ __forceinline__ f32x2 gelu_pk(f32x2 v) {
    const f32x2 av = __builtin_elementwise_abs(v), d = av * 0.2316418882f + 1.0f;
    f32x2 t; t.x = __builtin_amdgcn_rcpf(d.x); t.y = __builtin_amdgcn_rcpf(d.y);
    f32x2 q = t * 0.5307027145f + (-0.7265760135f); q = q * t + 0.7107068705f; q = q * t + (-0.142248368f); q = q * t + 0.127414796f; q = q * t;
    const f32x2 s = (v * v) * (-0.72134752044f);
    f32x2 e; e.x = __builtin_amdgcn_exp2f(s.x); e.y = __builtin_amdgcn_exp2f(s.y);
    const f32x2 m = v * (q * e), r = v - m;
    f32x2 o; o.x = v.x < 0.f ? m.x : r.x; o.y = v.y < 0.f ? m.y : r.y; return o;
}

template <int ACT  > struct EpiBf16 {
    static constexpr bool PERM = true, AFTER_DRAIN = false; static_assert(ACT == 0 || ACT == 1, "EpiBf16: ACT is 0 (none) or 1 (gelu_pk)");
    bf16_t* O; int ldc; const float* bias; int split_cols; size_t split_stride; float scale0;
    __device__ __forceinline__ void operator()(const f32x4 (&acc)[2][2][4][2], const Unit& u, int wr, int wc, int fr, int fq) const {
        const int row0 = u.pm * BM + wr * 64 + fr; int colt = u.pn * BM; bf16_t* base = O;
        float sc = 1.f; if (split_cols) { const int t = colt / split_cols; base += (size_t)t * split_stride; colt -= t * split_cols; if (t == 0) sc = scale0; }
        const int col0 = colt + wc * 32 + 8 * fq, bcol0 = u.pn * BM + wc * 32 + 8 * fq;
        f32x4 bv[2][2];
#pragma unroll
        for (int bj = 0; bj < 2; ++bj)
#pragma unroll
            for (int n = 0; n < 2; ++n) bv[bj][n] = bias ? *(const f32x4*)(bias + bcol0 + bj * HALF + 4 * n) : (f32x4){0.f, 0.f, 0.f, 0.f};
#pragma unroll
        for (int ai = 0; ai < 2; ++ai)
#pragma unroll
            for (int m = 0; m < 4; ++m) { bf16_t* rowp = base + (size_t)(row0 + ai * HALF + m * 16) * ldc + col0;
#pragma unroll
                for (int bj = 0; bj < 2; ++bj) { f32x4 v0 = acc[ai][bj][m][0] + bv[bj][0], v1 = acc[ai][bj][m][1] + bv[bj][1];
                    if (ACT == 1) { f32x2 a = gelu_pk((f32x2){v0[0], v0[1]}), b = gelu_pk((f32x2){v0[2], v0[3]}), c = gelu_pk((f32x2){v1[0], v1[1]}), d = gelu_pk((f32x2){v1[2], v1[3]});
                        v0 = (f32x4){a.x, a.y, b.x, b.y}; v1 = (f32x4){c.x, c.y, d.x, d.y}; }
                    v0 = v0 * sc; v1 = v1 * sc; u32x4 w; w.x = cvt_pk_bf16(v0[0], v0[1]); w.y = cvt_pk_bf16(v0[2], v0[3]); w.z = cvt_pk_bf16(v1[0], v1[1]); w.w = cvt_pk_bf16(v1[2], v1[3]);
                    *(u32x4*)(rowp + bj * HALF) = w; } }
    }
};

struct PanelStats {
    unsigned* xbuf;
    unsigned* cnt;
    unsigned* tmo;
    int ntn; float eps;
    unsigned code;
    __device__ __forceinline__ bool run(const f32x4 (&v)[2][2][4][2], const Unit& u, int wr, int wc, int fr, int fq, PG8_LAS unsigned char* lds, int wid, int lane) const {
        typedef float f32x2v __attribute__((ext_vector_type(2)));
        PG8_LAS f32x2v* P = (PG8_LAS f32x2v*)lds;
        PG8_LAS f32x2v* S = (PG8_LAS f32x2v*)(lds + 8192);
        PG8_LAS unsigned* flag = (PG8_LAS unsigned*)(lds + 8192 + 2048);
#pragma unroll
        for (int ai = 0; ai < 2; ++ai)
#pragma unroll
            for (int m = 0; m < 4; ++m) {
                float s = 0.f;
#pragma unroll
                for (int bj = 0; bj < 2; ++bj)
#pragma unroll
                    for (int n = 0; n < 2; ++n) { const f32x4 x = v[ai][bj][m][n]; s += (x[0] + x[1]) + (x[2] + x[3]); }
                s += __shfl_xor(s, 16); s += __shfl_xor(s, 32);
                const float mw = s * (1.0f / 64.0f); float q = 0.f;
#pragma unroll
                for (int bj = 0; bj < 2; ++bj)
#pragma unroll
                    for (int n = 0; n < 2; ++n) { const f32x4 d = v[ai][bj][m][n] - mw; q += (d[0] * d[0] + d[1] * d[1]) + (d[2] * d[2] + d[3] * d[3]); }
                q += __shfl_xor(q, 16); q += __shfl_xor(q, 32);
                if (fq == 0) P[(ai * HALF + wr * 64 + m * 16 + fr) * 4 + wc] = (f32x2v){mw, q};
            }
        asm volatile("s_waitcnt lgkmcnt(0)" ::: "memory"); __builtin_amdgcn_s_barrier(); asm volatile("" ::: "memory");
#if defined(BROKEN_EXCHANGE_NO_WAIT)
#warning BROKEN CONTROL BUILD: the row-statistics exchange does not wait; results are wrong by design
        if (blockIdx.x >= 64) { const long long t0_ = clock64(); while (clock64() - t0_ < 60000) __builtin_amdgcn_s_sleep(8); }
#endif
        const int row = wid * 32 + (lane & 31);
        if (lane < 32) {
            const f32x2v a = P[row * 4 + 0], b = P[row * 4 + 1], c = P[row * 4 + 2], d = P[row * 4 + 3];
            const float mt = (a.x + b.x + c.x + d.x) * 0.25f;
            const float da = a.x - mt, db = b.x - mt, dc = c.x - mt, dd = d.x - mt;
            const float m2 = (a.y + b.y) + (c.y + d.y) + 64.0f * ((da * da + db * db) + (dc * dc + dd * dd));
            unsigned long long* slot = (unsigned long long*)xbuf + ((size_t)(u.pm * BM + row) * 4 + u.pn);
            __hip_atomic_store(slot, ((unsigned long long)__float_as_uint(m2) << 32) | __float_as_uint(mt), __ATOMIC_RELAXED, __HIP_MEMORY_SCOPE_AGENT);
        }
        asm volatile("s_waitcnt vmcnt(0)" ::: "memory");
        if (lane == 0) __hip_atomic_fetch_add(cnt + 64 * u.pm, 1u, __ATOMIC_RELAXED, __HIP_MEMORY_SCOPE_AGENT);
        if (wid == 0) {
            bool dead = false; const unsigned long long t0 = __builtin_amdgcn_s_memrealtime(); const unsigned want = 8u * (unsigned)ntn;
            for (;;) {
#if defined(BROKEN_EXCHANGE_NO_WAIT)
                break;
#endif
                if ((unsigned)__builtin_amdgcn_readfirstlane(__hip_atomic_load(cnt + 64 * u.pm, __ATOMIC_RELAXED, __HIP_MEMORY_SCOPE_AGENT)) >= want) break;
                if (__builtin_amdgcn_s_memrealtime() - t0 > 2000000ull) {
                    if (lane == 0) { unsigned expect = 0u; __hip_atomic_compare_exchange_strong(tmo + 1, &expect, code | (unsigned)(u.pm & 0xff), __ATOMIC_RELAXED, __ATOMIC_RELAXED, __HIP_MEMORY_SCOPE_AGENT);
                                     __hip_atomic_store(tmo, 1u, __ATOMIC_RELAXED, __HIP_MEMORY_SCOPE_AGENT); }
                    dead = true; break; }
                __builtin_amdgcn_s_sleep(2);
            }
            __builtin_amdgcn_fence(__ATOMIC_ACQUIRE, "agent");
            if (lane == 0) flag[0] = dead ? 1u : 0u;
        }
        asm volatile("s_waitcnt vmcnt(0) lgkmcnt(0)" ::: "memory"); __builtin_amdgcn_s_barrier(); asm volatile("" ::: "memory");
        const bool bad = flag[0] != 0u;
        if (lane < 32) {
            const unsigned long long* slot = (const unsigned long long*)xbuf + (size_t)(u.pm * BM + row) * 4; float mt[4], m2[4]; float ms = 0.f;
#pragma unroll
            for (int t = 0; t < 4; ++t) { if (t < ntn) { const unsigned long long w = __hip_atomic_load(slot + t, __ATOMIC_RELAXED, __HIP_MEMORY_SCOPE_AGENT); mt[t] = __uint_as_float((unsigned)w); m2[t] = __uint_as_float((unsigned)(w >> 32)); } else { mt[t] = 0.f; m2[t] = 0.f; } ms += mt[t]; }
            const float mean = ms / (float)ntn; float q = 0.f;
#pragma unroll
            for (int t = 0; t < 4; ++t) if (t < ntn) { const float dm = mt[t] - mean; q += m2[t] + 256.0f * dm * dm; }
            S[row] = (f32x2v){mean, 1.0f / sqrtf(q / (256.0f * (float)ntn) + eps)};
        }
        asm volatile("s_waitcnt lgkmcnt(0)" ::: "memory"); __builtin_amdgcn_s_barrier(); asm volatile("" ::: "memory");
        return bad;
    }
};
struct EpiLnRes {
    static constexpr bool PERM = false, AFTER_DRAIN = true;
    const float* base; float* out; int ldc; const float* bias; PanelStats st; unsigned poison;
    __device__ __forceinline__ void fused(f32x4 (&acc)[2][2][4][2], const Unit& u, int wr, int wc, int fr, int fq, PG8_LAS unsigned char* lds, int wid, int lane) const {
        typedef float f32x2v __attribute__((ext_vector_type(2)));
        const PG8_LAS f32x2v* S = (const PG8_LAS f32x2v*)(lds + 8192);
        const int col0 = u.pn * BM + wc * 32 + 4 * fq;
#pragma unroll
        for (int bj = 0; bj < 2; ++bj)
#pragma unroll
            for (int n = 0; n < 2; ++n) { const f32x4 bv = bias ? *(const f32x4*)(bias + col0 + bj * HALF + n * 16) : (f32x4){0.f, 0.f, 0.f, 0.f};
#pragma unroll
                for (int ai = 0; ai < 2; ++ai)
#pragma unroll
                    for (int m = 0; m < 4; ++m) acc[ai][bj][m][n] += bv; }
        f32x4 pre[4][2][2];
#pragma unroll
        for (int m = 0; m < 4; ++m) { const size_t off = (size_t)(u.pm * BM + wr * 64 + m * 16 + fr) * ldc + col0;
#pragma unroll
            for (int bj = 0; bj < 2; ++bj)
#pragma unroll
                for (int n = 0; n < 2; ++n) pre[m][bj][n] = *(const f32x4*)(base + off + bj * HALF + n * 16); }
        const bool bad = st.run(acc, u, wr, wc, fr, fq, lds, wid, lane) || poison != 0u;
        const float qnan = __builtin_nanf("");
#pragma unroll
        for (int ai = 0; ai < 2; ++ai)
#pragma unroll
            for (int m = 0; m < 4; ++m) { const int r = ai * HALF + wr * 64 + m * 16 + fr; const f32x2v sr = S[r]; const size_t off = (size_t)(u.pm * BM + r) * ldc + col0;
#pragma unroll
                for (int bj = 0; bj < 2; ++bj)
#pragma unroll
                    for (int n = 0; n < 2; ++n) { const f32x4 bs = ai == 0 ? pre[m][bj][n] : *(const f32x4*)(base + off + bj * HALF + n * 16); f32x4 o = bs + (acc[ai][bj][m][n] - sr.x) * sr.y;
                        if (bad) o = (f32x4){qnan, qnan, qnan, qnan}; *(f32x4*)(out + off + bj * HALF + n * 16) = o; }
                if (m & 1) asm volatile("" ::: "memory"); }
    }
};
struct EpiLnResLn {
    static constexpr bool PERM = false, AFTER_DRAIN = true;
    const float* base; float* out; bf16_t* xn; int ldc; const float* bias; PanelStats st1, st2; unsigned poison;
    __device__ __forceinline__ void fused(f32x4 (&acc)[2][2][4][2], const Unit& u, int wr, int wc, int fr, int fq, PG8_LAS unsigned char* lds, int wid, int lane) const {
        typedef float f32x2v __attribute__((ext_vector_type(2))); typedef unsigned u32x2v __attribute__((ext_vector_type(2)));
        const PG8_LAS f32x2v* S = (const PG8_LAS f32x2v*)(lds + 8192);
        const int col0 = u.pn * BM + wc * 32 + 4 * fq;
#pragma unroll
        for (int bj = 0; bj < 2; ++bj)
#pragma unroll
            for (int n = 0; n < 2; ++n) { const f32x4 bv = bias ? *(const f32x4*)(bias + col0 + bj * HALF + n * 16) : (f32x4){0.f, 0.f, 0.f, 0.f};
#pragma unroll
                for (int ai = 0; ai < 2; ++ai)
#pragma unroll
                    for (int m = 0; m < 4; ++m) acc[ai][bj][m][n] += bv; }
        bool bad = st1.run(acc, u, wr, wc, fr, fq, lds, wid, lane) || poison != 0u;
        const float qnan = __builtin_nanf("");
#pragma unroll
        for (int ai = 0; ai < 2; ++ai)
#pragma unroll
            for (int m = 0; m < 4; ++m) { const int r = ai * HALF + wr * 64 + m * 16 + fr; const f32x2v sr = S[r]; const size_t off = (size_t)(u.pm * BM + r) * ldc + col0;
#pragma unroll
                for (int bj = 0; bj < 2; ++bj)
#pragma unroll
                    for (int n = 0; n < 2; ++n) { const f32x4 bs = *(const f32x4*)(base + off + bj * HALF + n * 16); acc[ai][bj][m][n] = bs + (acc[ai][bj][m][n] - sr.x) * sr.y; }
                asm volatile("" : "+v"(acc[ai][0][m][0]), "+v"(acc[ai][0][m][1]), "+v"(acc[ai][1][m][0]), "+v"(acc[ai][1][m][1]));
                if (m & 1) asm volatile("" ::: "memory"); }
        const bool bad1 = bad;
        bad = st2.run(acc, u, wr, wc, fr, fq, lds, wid, lane) || bad;
#pragma unroll
        for (int ai = 0; ai < 2; ++ai)
#pragma unroll
            for (int m = 0; m < 4; ++m) { const int r = ai * HALF + wr * 64 + m * 16 + fr; const f32x2v sr = S[r]; const size_t off = (size_t)(u.pm * BM + r) * ldc + col0;
#pragma unroll
                for (int bj = 0; bj < 2; ++bj)
#pragma unroll
                    for (int n = 0; n < 2; ++n) { const f32x4 x1 = acc[ai][bj][m][n]; *(f32x4*)(out + off + bj * HALF + n * 16) = bad1 ? (f32x4){qnan, qnan, qnan, qnan} : x1;
                        const f32x4 o = (x1 - sr.x) * sr.y; u32x2v w; w.x = cvt_pk_bf16(o[0], o[1]); w.y = cvt_pk_bf16(o[2], o[3]);
                        if (bad) { w.x = 0x7fc07fc0u; w.y = 0x7fc07fc0u; } *(u32x2v*)(xn + off + bj * HALF + n * 16) = w; }
                asm volatile("" ::: "memory"); }
    }
};

template <class Epi, class Sched, bool ALIGN_EPI = false, bool SP2 = false>
__device__ __forceinline__ void gemm_phase(PG8_LAS unsigned char* lds, const Gemm g, const Sched& S, const Epi& E) {
    int tid_ = threadIdx.x; asm volatile("" : "+v"(tid_));
    const int tid = tid_, wid = __builtin_amdgcn_readfirstlane(tid >> 6), lane = tid & 63, wr = wid >> 2, wc = wid & 3, fr = lane & 15, fq = lane >> 4;
    const int K = g.K, nt = K / BK;
    unsigned voffA[2], voffB[2];
#pragma unroll
    for (int i = 0; i < 2; ++i) { int R, C; stage_rc(tid * 16 + i * 8192, R, C); const int Rb = Epi::PERM ? ((R & ~31) + perm32(R & 31)) : R;
        voffA[i] = (unsigned)(R * K + C) * 2u; voffB[i] = (unsigned)(Rb * K + C) * 2u; }
    const size_t kstep = (size_t)(BK * 2);
    const size_t hstep = (size_t)HALF * K * 2;
    const size_t tstep = 2 * hstep;
    const unsigned ldsw = (unsigned)wid * 1024u;
    const int aoff = lds_byte(wr * 64 + fr, fq * 8), boff = lds_byte(wc * 32 + fr, fq * 8);
#define PG8_SA(b, h) (((b) * 2 + (h)) * HTB)
#define PG8_SB(b, h) ((4 + (b) * 2 + (h)) * HTB)
#define PG8_STAGE(bufoff, gbase, voff) do { _Pragma("unroll") for (int _i = 0; _i < 2; ++_i) \
        __builtin_amdgcn_global_load_lds((const unsigned*)((const char*)(gbase) + (voff)[_i]), (PG8_LAS unsigned*)(lds + (bufoff) + ldsw + _i * 8192), 16, 0, 0); } while (0)
#define PG8_LDA(dst, b, h) do { _Pragma("unroll") for (int m = 0; m < 4; ++m) _Pragma("unroll") for (int k = 0; k < 2; ++k) dst[m][k] = *(const PG8_LAS bf16x8*)(lds + PG8_SA(b, h) + aoff + m * 2048 + k * 1024); } while (0)
#define PG8_LDB(dst, b, h) do { _Pragma("unroll") for (int n = 0; n < 2; ++n) _Pragma("unroll") for (int k = 0; k < 2; ++k) dst[n][k] = *(const PG8_LAS bf16x8*)(lds + PG8_SB(b, h) + boff + n * 2048 + k * 1024); } while (0)
#define PG8_MMA(ai, bj, At, Bt) do { __builtin_amdgcn_s_setprio(1); _Pragma("unroll") for (int m = 0; m < 4; ++m) _Pragma("unroll") for (int n = 0; n < 2; ++n) _Pragma("unroll") for (int k = 0; k < 2; ++k) \
        acc[ai][bj][m][n] = __builtin_amdgcn_mfma_f32_16x16x32_bf16(Bt[n][k], At[m][k], acc[ai][bj][m][n], 0, 0, 0); __builtin_amdgcn_s_setprio(0); } while (0)
#define PG8_WAIT_V(n) asm volatile("s_waitcnt vmcnt(" #n ")" ::: "memory")
#define PG8_WAIT_L(n) asm volatile("s_waitcnt lgkmcnt(" #n ")" ::: "memory")
#define PG8_BAR __builtin_amdgcn_s_barrier()
#define PG8_SCHED __builtin_amdgcn_sched_barrier(0)
    Unit cur, nxt; int ui = 0;
    if (!S.next(0, cur)) return;
    f32x4 acc[2][2][4][2];
#pragma unroll
    for (int a = 0; a < 2; ++a)
#pragma unroll
        for (int b = 0; b < 2; ++b)
#pragma unroll
            for (int m = 0; m < 4; ++m)
#pragma unroll
                for (int n = 0; n < 2; ++n) acc[a][b][m][n] = (f32x4){0.f, 0.f, 0.f, 0.f};
    bf16x8 At[4][2], B0[2][2], B1[2][2];
    const char* cA = (const char*)g.A + (size_t)cur.pm * tstep; const char* cB = (const char*)g.Bt + (size_t)cur.pn * tstep;
    S.a_ready(cur);
    if constexpr (SP2) {
        PG8_STAGE(PG8_SB(0, 0), cB, voffB); PG8_STAGE(PG8_SB(0, 1), cB + hstep, voffB); PG8_STAGE(PG8_SA(0, 0), cA, voffA); PG8_STAGE(PG8_SA(0, 1), cA + hstep, voffA);
        if (wr == 1) PG8_BAR;
        PG8_WAIT_V(2); PG8_BAR;
        PG8_STAGE(PG8_SB(1, 0), cB + kstep, voffB); PG8_STAGE(PG8_SA(1, 0), cA + kstep, voffA); PG8_STAGE(PG8_SB(1, 1), cB + hstep + kstep, voffB);
        PG8_WAIT_V(6); PG8_BAR;
    } else {
        PG8_STAGE(PG8_SB(0, 0), cB, voffB); PG8_STAGE(PG8_SA(0, 0), cA, voffA); PG8_STAGE(PG8_SB(0, 1), cB + hstep, voffB); PG8_STAGE(PG8_SA(0, 1), cA + hstep, voffA);
        if (wr == 1) PG8_BAR;
        PG8_WAIT_V(4); PG8_BAR;
        PG8_STAGE(PG8_SB(1, 0), cB + kstep, voffB); PG8_STAGE(PG8_SA(1, 0), cA + kstep, voffA); PG8_STAGE(PG8_SB(1, 1), cB + hstep + kstep, voffB);
        PG8_WAIT_V(6); PG8_BAR;
    }
    for (;;) {
        const bool has_next = S.next(ui + 1, nxt);
        const char* nA = has_next ? (const char*)g.A + (size_t)nxt.pm * tstep : cA; const char* nB = has_next ? (const char*)g.Bt + (size_t)nxt.pn * tstep : cB;
        for (int t = 0; t < nt; t += 2) {
            const bool last = (t == nt - 2);
            const char* a1 = cA + (size_t)(t + 1) * kstep;
            const char* a2 = last ? nA : cA + (size_t)(t + 2) * kstep; const char* b2 = last ? nB : cB + (size_t)(t + 2) * kstep;
            const char* a3 = a2 + kstep; const char* b3 = b2 + kstep;
            if (last && has_next) S.a_ready(nxt);
            if constexpr (SP2) {
            PG8_LDB(B0, 0, 0); PG8_LDB(B1, 0, 1); PG8_SCHED; PG8_LDA(At, 0, 0); PG8_STAGE(PG8_SA(1, 1), a1 + hstep, voffA);
            PG8_WAIT_V(8); PG8_WAIT_L(0); PG8_BAR; PG8_MMA(0, 0, At, B0); PG8_MMA(0, 1, At, B1); PG8_BAR; PG8_SCHED;
            PG8_LDA(At, 0, 1); PG8_STAGE(PG8_SB(0, 0), b2, voffB); PG8_STAGE(PG8_SB(0, 1), b2 + hstep, voffB); PG8_STAGE(PG8_SA(0, 0), a2, voffA);
            PG8_WAIT_V(8); PG8_WAIT_L(0); PG8_BAR; PG8_MMA(1, 0, At, B0); PG8_MMA(1, 1, At, B1); PG8_BAR; PG8_SCHED;
            PG8_LDB(B0, 1, 0); PG8_LDB(B1, 1, 1); PG8_SCHED; PG8_LDA(At, 1, 0); PG8_STAGE(PG8_SA(0, 1), a2 + hstep, voffA);
            PG8_WAIT_V(8); PG8_WAIT_L(0); PG8_BAR; PG8_MMA(0, 0, At, B0); PG8_MMA(0, 1, At, B1); PG8_BAR; PG8_SCHED;
            PG8_LDA(At, 1, 1); PG8_STAGE(PG8_SB(1, 0), b3, voffB); PG8_STAGE(PG8_SB(1, 1), b3 + hstep, voffB); PG8_STAGE(PG8_SA(1, 0), a3, voffA);
            PG8_WAIT_V(8); PG8_WAIT_L(0); PG8_BAR; PG8_MMA(1, 0, At, B0); PG8_MMA(1, 1, At, B1); PG8_BAR; PG8_SCHED;
            } else {
            PG8_LDB(B0, 0, 0); PG8_SCHED; PG8_LDA(At, 0, 0); PG8_STAGE(PG8_SA(1, 1), a1 + hstep, voffA);
            PG8_WAIT_L(8); PG8_BAR; PG8_WAIT_L(0); PG8_MMA(0, 0, At, B0); PG8_BAR; PG8_SCHED;
            PG8_LDB(B1, 0, 1); PG8_STAGE(PG8_SB(0, 0), b2, voffB);
            PG8_BAR; PG8_WAIT_L(0); PG8_MMA(0, 1, At, B1); PG8_BAR;
            PG8_LDA(At, 0, 1); PG8_STAGE(PG8_SA(0, 0), a2, voffA);
            PG8_BAR; PG8_WAIT_L(0); PG8_MMA(1, 0, At, B0); PG8_BAR; PG8_SCHED;
            PG8_STAGE(PG8_SB(0, 1), b2 + hstep, voffB);
            PG8_WAIT_V(6); PG8_BAR; PG8_MMA(1, 1, At, B1); PG8_BAR;
            PG8_LDB(B0, 1, 0); PG8_SCHED; PG8_LDA(At, 1, 0); PG8_STAGE(PG8_SA(0, 1), a2 + hstep, voffA);
            PG8_WAIT_L(8); PG8_BAR; PG8_WAIT_L(0); PG8_MMA(0, 0, At, B0); PG8_BAR; PG8_SCHED;
            PG8_LDB(B1, 1, 1); PG8_STAGE(PG8_SB(1, 0), b3, voffB);
            PG8_BAR; PG8_WAIT_L(0); PG8_MMA(0, 1, At, B1); PG8_BAR;
            PG8_LDA(At, 1, 1); PG8_STAGE(PG8_SA(1, 0), a3, voffA);
            PG8_BAR; PG8_WAIT_L(0); PG8_MMA(1, 0, At, B0); PG8_BAR; PG8_SCHED;
            PG8_STAGE(PG8_SB(1, 1), b3 + hstep, voffB);
            PG8_WAIT_V(6); PG8_BAR; PG8_MMA(1, 1, At, B1); PG8_BAR;
            }
        }
        if constexpr (ALIGN_EPI) { if (wr == 0) PG8_BAR; }
        if constexpr (!Epi::AFTER_DRAIN) { E(acc, cur, wr, wc, fr, fq); S.done(cur); }
        if (!has_next) break;
#pragma unroll
        for (int a = 0; a < 2; ++a)
#pragma unroll
            for (int b = 0; b < 2; ++b)
#pragma unroll
                for (int m = 0; m < 4; ++m)
#pragma unroll
                    for (int n = 0; n < 2; ++n) acc[a][b][m][n] = (f32x4){0.f, 0.f, 0.f, 0.f};
        cur = nxt; cA = nA; cB = nB; ++ui;
        if constexpr (ALIGN_EPI) { if (wr == 1) PG8_BAR; }
    }
    PG8_WAIT_V(0);
    if constexpr (!ALIGN_EPI) { if (wr == 0) PG8_BAR; }
    PG8_BAR;
    if constexpr (Epi::AFTER_DRAIN) { E.fused(acc, cur, wr, wc, fr, fq, lds, wid, lane); S.done(cur); }
#undef PG8_SA
#undef PG8_SB
#undef PG8_STAGE
#undef PG8_LDA
#undef PG8_LDB
#undef PG8_MMA
#undef PG8_WAIT_V
#undef PG8_WAIT_L
#undef PG8_BAR
#undef PG8_SCHED
}
}

namespace cg = cooperative_groups;
#define LAS __attribute__((address_space(3)))
typedef unsigned short bf16;
typedef unsigned v4u __attribute__((ext_vector_type(4)));
typedef float f32x4 __attribute__((ext_vector_type(4)));
typedef const __attribute__((address_space(4))) float cfloat;

constexpr int NWAVES = 8, NTHR = 512;
constexpr int DM = 1024, BATCH = 8, SEQ = 2048, DEPTH = 4, M = BATCH * SEQ;
constexpr int CW = 384, PWID = 256, SW = 384, INW = 2176, PW = 2304  , DFF = 2816, CHUNK = 128;
constexpr float LN_EPS = 1e-5f;
constexpr float ALPHA = 1.681792830507429f;
constexpr int PC_U = 0, PC_V = 384, PC_XA = 768, PC_GB = 1152, PC_GC = 1536, PC_P = 1920;
constexpr size_t MiB = 1u << 20;
constexpr size_t WS_W = 1 * MiB, WS_AB = 24 * MiB, WS_MIX = 56 * MiB, WS_Y = 88 * MiB, WS_R1 = 152 * MiB, WS_END = 240 * MiB;
constexpr size_t WOFF_IN = 0, WOFF_O = (size_t)PW * DM, WOFF_GU = WOFF_O + (size_t)DM * DM, WOFF_DN = WOFF_GU + (size_t)2 * DFF * DM;
static_assert((WOFF_DN + (size_t)DM * DFF) * 2 + WS_W <= WS_AB, "weights fit");
constexpr int LDS_BYTES = 147456;

__device__ __forceinline__ unsigned f2bf(float f) { unsigned u = __builtin_bit_cast(unsigned, f); return (u + 0x7fffu + ((u >> 16) & 1u)) >> 16; }
__device__ __forceinline__ unsigned pk2(float lo, float hi) { return f2bf(lo) | (f2bf(hi) << 16); }
__device__ __forceinline__ float bflo(unsigned w) { return __builtin_bit_cast(float, w << 16); }
__device__ __forceinline__ float bfhi(unsigned w) { return __builtin_bit_cast(float, w & 0xffff0000u); }
__device__ __forceinline__ float wave_sum(float v) {
#pragma unroll
    for (int o = 1; o < 64; o <<= 1) v += __shfl_xor(v, o);
    return v;
}
#define UNPACK8(V_, f, o) do { f[o+0] = bflo((V_).x); f[o+1] = bfhi((V_).x); f[o+2] = bflo((V_).y); f[o+3] = bfhi((V_).y); f[o+4] = bflo((V_).z); f[o+5] = bfhi((V_).z); f[o+6] = bflo((V_).w); f[o+7] = bfhi((V_).w); } while (0)

__device__ __forceinline__ int fresh_tid() { int t = threadIdx.x; asm volatile("" : "+v"(t)); return t; }
struct Args {
    const float *x, *w_in, *w_conv, *w_pool, *pool_scale, *sgu_ln_g, *w_spatial, *b_spatial, *w_o, *ln1_g, *ln1_b, *w_gate_up, *w_down, *ln2_g, *ln2_b;
    float* out; unsigned char* ws;
};

struct EpiProj {
    static constexpr bool PERM = true, AFTER_DRAIN = false;
    bf16* O; int ldc; int gelu_tiles;
    __device__ __forceinline__ void operator()(const pg8::f32x4 (&acc)[2][2][4][2], const pg8::Unit& u, int wr, int wc, int fr, int fq) const {
        using namespace pg8;
        const int row0 = u.pm * BM + wr * 64 + fr, col0 = u.pn * BM + wc * 32 + 8 * fq;
        const bool act = u.pn < gelu_tiles;
#pragma unroll
        for (int ai = 0; ai < 2; ++ai)
#pragma unroll
            for (int m = 0; m < 4; ++m) { bf16* rowp = O + (size_t)(row0 + ai * HALF + m * 16) * ldc + col0;
#pragma unroll
                for (int bj = 0; bj < 2; ++bj) { pg8::f32x4 v0 = acc[ai][bj][m][0], v1 = acc[ai][bj][m][1];
                    if (act) { f32x2 a = gelu_pk((f32x2){v0[0], v0[1]}), b = gelu_pk((f32x2){v0[2], v0[3]}), c = gelu_pk((f32x2){v1[0], v1[1]}), d = gelu_pk((f32x2){v1[2], v1[3]});
                        v0 = (pg8::f32x4){a.x, a.y, b.x, b.y}; v1 = (pg8::f32x4){c.x, c.y, d.x, d.y}; }
                    u32x4 w; w.x = cvt_pk_bf16(v0[0], v0[1]); w.y = cvt_pk_bf16(v0[2], v0[3]); w.z = cvt_pk_bf16(v1[0], v1[1]); w.w = cvt_pk_bf16(v1[2], v1[3]);
                    *(u32x4*)(rowp + bj * HALF) = w; } }
    }
};
struct EpiRes {
    static constexpr bool PERM = false, AFTER_DRAIN = false;
    const float* X; float* Y; int ldc; float alpha;
    __device__ __forceinline__ void operator()(const pg8::f32x4 (&acc)[2][2][4][2], const pg8::Unit& u, int wr, int wc, int fr, int fq) const {
        using namespace pg8;
        const int row0 = u.pm * BM + wr * 64 + fr, col0 = u.pn * BM + wc * 32 + 4 * fq;
#pragma unroll
        for (int ai = 0; ai < 2; ++ai)
#pragma unroll
            for (int m = 0; m < 4; ++m) { const size_t off = (size_t)(row0 + ai * HALF + m * 16) * ldc + col0;
#pragma unroll
                for (int bj = 0; bj < 2; ++bj)
#pragma unroll
                    for (int n = 0; n < 2; ++n) { const pg8::f32x4 xv = *(const pg8::f32x4*)(X + off + bj * HALF + n * 16);
                        *(pg8::f32x4*)(Y + off + bj * HALF + n * 16) = xv * alpha + acc[ai][bj][m][n]; }
                asm volatile("" ::: "memory"); }
    }
};
struct EpiSwiglu {
    static constexpr bool PERM = true, AFTER_DRAIN = false;
    bf16* H; int ldc;
    __device__ __forceinline__ void operator()(const pg8::f32x4 (&acc)[2][2][4][2], const pg8::Unit& u, int wr, int wc, int fr, int fq) const {
        using namespace pg8;
        const int row0 = u.pm * BM + wr * 64 + fr, col0 = u.pn * HALF + wc * 32 + 8 * fq;
#pragma unroll
        for (int ai = 0; ai < 2; ++ai)
#pragma unroll
            for (int m = 0; m < 4; ++m) { bf16* rowp = H + (size_t)(row0 + ai * HALF + m * 16) * ldc + col0;
                float h[8];
#pragma unroll
                for (int n = 0; n < 2; ++n)
#pragma unroll
                    for (int j = 0; j < 4; ++j) { const float g = acc[ai][0][m][n][j], uu = acc[ai][1][m][n][j];
                        const float s = __builtin_amdgcn_rcpf(1.0f + __builtin_amdgcn_exp2f(g * -1.4426950408889634f)); h[n * 4 + j] = g * s * uu; }
                u32x4 w; w.x = cvt_pk_bf16(h[0], h[1]); w.y = cvt_pk_bf16(h[2], h[3]); w.z = cvt_pk_bf16(h[4], h[5]); w.w = cvt_pk_bf16(h[6], h[7]);
                *(u32x4*)rowp = w; }
    }
};

__device__ __forceinline__ void transpose_item(const float* W, int K, int N, bf16* WT, int k0, int n0, int drow0, LAS float* scr, int lane) {
#pragma unroll 8
    for (int i = 0; i < 32; ++i) { const int kk = 2 * i + (lane >> 5); scr[kk * 33 + (lane & 31)] = W[(size_t)(k0 + kk) * N + n0 + (lane & 31)]; }
    asm volatile("s_waitcnt lgkmcnt(0)" ::: "memory");
    const int c = lane & 7;
#pragma unroll
    for (int j = 0; j < 4; ++j) { const int n = (lane >> 3) + 8 * j; const LAS float* s = scr + (8 * c) * 33 + n;
        v4u o; o.x = pk2(s[0 * 33], s[1 * 33]); o.y = pk2(s[2 * 33], s[3 * 33]); o.z = pk2(s[4 * 33], s[5 * 33]); o.w = pk2(s[6 * 33], s[7 * 33]);
        *(v4u*)(WT + (size_t)(drow0 + n) * K + k0 + 8 * c) = o; }
    asm volatile("s_waitcnt lgkmcnt(0)" ::: "memory");
}
__device__ __forceinline__ void convert_layer(const Args& a, int l, LAS unsigned char* lds, int G, int bx) {
    const int tid = fresh_tid(), lane = tid & 63, wave = __builtin_amdgcn_readfirstlane(tid >> 6), gw = bx * NWAVES + wave, NGW = G * NWAVES;
    LAS float* scr = (LAS float*)(lds + wave * 16384);
    bf16* Wb = (bf16*)(a.ws + WS_W);
    constexpr int I_IN = 16 * 68, I_O = 16 * 32, I_GU = 16 * 176, I_DN = 44 * 32, I_PAD = 128;
    constexpr int NIT = I_IN + I_O + I_GU + I_DN + I_PAD;
    for (int it = gw; it < NIT; it += NGW) {
        int r = it;
        if (r < I_IN) { const int kb = r / 68, nb = r % 68, n0 = 32 * nb; const int dr = n0 < 1408 ? n0 + 768 : n0 - 1408;
            transpose_item(a.w_in + (size_t)l * DM * INW, DM, INW, Wb + WOFF_IN, 64 * kb, n0, dr, scr, lane); continue; } r -= I_IN;
        if (r < I_O) { const int kb = r / 32, nb = r % 32; transpose_item(a.w_o + (size_t)l * DM * DM, DM, DM, Wb + WOFF_O, 64 * kb, 32 * nb, 32 * nb, scr, lane); continue; } r -= I_O;
        if (r < I_GU) { const int kb = r / 176, nb = r % 176, n0 = 32 * nb; int dr;
            if (n0 < DFF) dr = 256 * (n0 / 128) + (n0 % 128); else { const int n1 = n0 - DFF; dr = 256 * (n1 / 128) + 128 + (n1 % 128); }
            transpose_item(a.w_gate_up + (size_t)l * DM * 2 * DFF, DM, 2 * DFF, Wb + WOFF_GU, 64 * kb, n0, dr, scr, lane); continue; } r -= I_GU;
        if (r < I_DN) { const int kb = r / 32, nb = r % 32; transpose_item(a.w_down + (size_t)l * DFF * DM, DFF, DM, Wb + WOFF_DN, 64 * kb, 32 * nb, 32 * nb, scr, lane); continue; } r -= I_DN;
        { v4u z = (v4u){0u, 0u, 0u, 0u}; v4u* p = (v4u*)(Wb + WOFF_IN + (size_t)(INW + r) * DM) + lane * 2; p[0] = z; p[1] = z; }
    }
}

__device__ __forceinline__ void ln_rows(const float* Y, const float* g, const float* b, float* of, bf16* ob, int G, int bx) {
    const int tid = fresh_tid(), lane = tid & 63, wave = __builtin_amdgcn_readfirstlane(tid >> 6), gw = bx * NWAVES + wave, NGW = G * NWAVES;
    f32x4 gv[4], bv[4];
#pragma unroll
    for (int j = 0; j < 4; ++j) { gv[j] = ((const f32x4*)g)[lane + 64 * j]; bv[j] = ((const f32x4*)b)[lane + 64 * j]; }
    for (int m = gw; m < M; m += NGW) {
        const f32x4* xr = (const f32x4*)(Y + (size_t)m * DM) + lane;
        f32x4 v[4]; float s = 0.f;
#pragma unroll
        for (int j = 0; j < 4; ++j) { v[j] = xr[64 * j]; s += (v[j].x + v[j].y) + (v[j].z + v[j].w); }
        const float mean = wave_sum(s) * (1.f / DM); float s2 = 0.f;
#pragma unroll
        for (int j = 0; j < 4; ++j) { v[j] = v[j] - mean; s2 += (v[j].x * v[j].x + v[j].y * v[j].y) + (v[j].z * v[j].z + v[j].w * v[j].w); }
        const float rstd = 1.f / sqrtf(wave_sum(s2) * (1.f / DM) + LN_EPS);
        f32x4* o4 = (f32x4*)(of + (size_t)m * DM) + lane;
        unsigned long long* o8 = (unsigned long long*)(ob + (size_t)m * DM) + lane;
#pragma unroll
        for (int j = 0; j < 4; ++j) { const f32x4 o = v[j] * rstd * gv[j] + bv[j]; o4[64 * j] = o;
            o8[64 * j] = (unsigned long long)pk2(o.x, o.y) | ((unsigned long long)pk2(o.z, o.w) << 32); }
    }
}
__device__ __forceinline__ void cvt_rows(const float* X, bf16* ob, int G, int bx) {
    const int tid = fresh_tid(), lane = tid & 63, wave = __builtin_amdgcn_readfirstlane(tid >> 6), gw = bx * NWAVES + wave, NGW = G * NWAVES;
    for (int m = gw; m < M; m += NGW) {
        const f32x4* xr = (const f32x4*)(X + (size_t)m * DM) + lane;
        unsigned long long* o8 = (unsigned long long*)(ob + (size_t)m * DM) + lane;
#pragma unroll
        for (int j = 0; j < 4; ++j) { const f32x4 o = xr[64 * j]; o8[64 * j] = (unsigned long long)pk2(o.x, o.y) | ((unsigned long long)pk2(o.z, o.w) << 32); }
    }
}

__device__ __forceinline__ void mix_sgu(const Args& a, int l, int ck, int h, LAS unsigned char* lds) {
    const int tid = fresh_tid(), lane = tid & 63, wave = __builtin_amdgcn_readfirstlane(tid >> 6);
    const bf16* P = (const bf16*)(a.ws + WS_R1); bf16* MX = (bf16*)(a.ws + WS_MIX);
    LAS float* vt = (LAS float*)lds;
    const int row0 = ck * CHUNK;
    {
        const int s = tid >> 2, q = tid & 3;
        const v4u* src = (const v4u*)(P + (size_t)(row0 + s) * PW + PC_V + 64 * h + 16 * q);
        const v4u w0 = src[0], w1 = src[1]; float f[16]; UNPACK8(w0, f, 0); UNPACK8(w1, f, 8);
        float sm = 0.f;
#pragma unroll
        for (int j = 0; j < 16; ++j) sm += f[j];
        sm += __shfl_xor(sm, 1); sm += __shfl_xor(sm, 2);
        const float mean = sm * (1.f / 64.f); float s2 = 0.f;
#pragma unroll
        for (int j = 0; j < 16; ++j) { f[j] -= mean; s2 += f[j] * f[j]; }
        s2 += __shfl_xor(s2, 1); s2 += __shfl_xor(s2, 2);
        const float rstd = 1.f / sqrtf(s2 * (1.f / 64.f) + LN_EPS);
        const f32x4* gp = (const f32x4*)(a.sgu_ln_g + (size_t)l * SW + 64 * h + 16 * q);
#pragma unroll
        for (int j4 = 0; j4 < 4; ++j4) { const f32x4 gv = gp[j4]; f32x4 o; o.x = f[4 * j4] * rstd * gv.x; o.y = f[4 * j4 + 1] * rstd * gv.y; o.z = f[4 * j4 + 2] * rstd * gv.z; o.w = f[4 * j4 + 3] * rstd * gv.w;
            *(LAS f32x4*)(vt + s * 64 + 16 * q + 4 * j4) = o; }
    }
    __syncthreads();
    float acc[16];
#pragma unroll
    for (int i = 0; i < 16; ++i) acc[i] = 0.f;
    cfloat* Wc = (cfloat*)(a.w_spatial + (size_t)(l * 6 + h) * CHUNK * CHUNK);
#pragma unroll 1
    for (int sb = 0; sb < 8; ++sb) {
        float vr[16];
#pragma unroll
        for (int j = 0; j < 16; ++j) vr[j] = vt[(16 * sb + j) * 64 + lane];
#pragma unroll
        for (int i = 0; i < 16; ++i) {
            if (i >= 2 * sb) {
                const int t = wave + 8 * i;
                cfloat* wrow = Wc + t * CHUNK + 16 * sb;
#pragma unroll
                for (int j = 0; j < 16; ++j) { float wv = wrow[j]; wv = (16 * sb + j <= t) ? wv : 0.f; acc[i] += wv * vr[j]; }
            }
        }
    }
    const float* bs = a.b_spatial + (size_t)(l * 6 + h) * CHUNK;
#pragma unroll
    for (int i = 0; i < 16; ++i) { const int t = wave + 8 * i;
        const float u = bflo((unsigned)P[(size_t)(row0 + t) * PW + PC_U + 64 * h + lane]);
        MX[(size_t)(row0 + t) * DM + 640 + 64 * h + lane] = (bf16)f2bf(u * (acc[i] + bs[t])); }
    __syncthreads();
}
__device__ __forceinline__ void mix_pool(const Args& a, int l, int ck, int g, LAS unsigned char* lds) {
    const int tid = fresh_tid(), lane = tid & 63, wave = __builtin_amdgcn_readfirstlane(tid >> 6);
    const bf16* P = (const bf16*)(a.ws + WS_R1); bf16* MX = (bf16*)(a.ws + WS_MIX);
    LAS float* pt = (LAS float*)lds;
    LAS float* dt = pt + 144 * 64;
    LAS float* wp = (LAS float*)(lds + 73728);
    const int row0 = ck * CHUNK; const bool first = (ck % (SEQ / CHUNK)) == 0; const int win = 2 << g;
    {   const int r = tid >> 2, q = tid & 3;
        const v4u* src = (const v4u*)(P + (size_t)(row0 + r) * PW + PC_P + 64 * g + 16 * q);
        const v4u w0 = src[0], w1 = src[1]; float f[16]; UNPACK8(w0, f, 0); UNPACK8(w1, f, 8);
#pragma unroll
        for (int j = 0; j < 16; ++j) pt[(16 + r) * 64 + 16 * q + j] = f[j];
        if (tid < 64) {
            float hf[16];
            if (first) {
#pragma unroll
                for (int j = 0; j < 16; ++j) hf[j] = 0.f;
            } else { const v4u* hs = (const v4u*)(P + (size_t)(row0 - 16 + r) * PW + PC_P + 64 * g + 16 * q); const v4u h0 = hs[0], h1 = hs[1]; UNPACK8(h0, hf, 0); UNPACK8(h1, hf, 8); }
#pragma unroll
            for (int j = 0; j < 16; ++j) pt[r * 64 + 16 * q + j] = hf[j];
        }
        const f32x4* ws = (const f32x4*)(a.w_pool + (size_t)(l * 4 + g) * 64 * 64) + tid * 2;
        const f32x4 x0 = ws[0], x1 = ws[1]; *(LAS f32x4*)(wp + tid * 8) = x0; *(LAS f32x4*)(wp + tid * 8 + 4) = x1;
    }
    __syncthreads();
    {   const int tb = (ck % (SEQ / CHUNK)) * CHUNK;
#pragma unroll 4
        for (int i = 0; i < 16; ++i) { const int t = wave + 8 * i; float s = 0.f;
            for (int j = 0; j < win; ++j) s += pt[(16 + t - j) * 64 + lane];
            const int cnt = (tb + t + 1) < win ? (tb + t + 1) : win;
            dt[t * 65 + lane] = s / (float)cnt - pt[(16 + t) * 64 + lane]; }
    }
    __syncthreads();
    {   const int t = tid >> 2, q = tid & 3; float acc[16];
#pragma unroll
        for (int j = 0; j < 16; ++j) acc[j] = 0.f;
#pragma unroll 4
        for (int c = 0; c < 64; ++c) { const float dv = dt[t * 65 + c];
#pragma unroll
            for (int j4 = 0; j4 < 4; ++j4) { const f32x4 wv = *(const LAS f32x4*)(wp + c * 64 + 16 * q + 4 * j4);
                acc[4 * j4] += dv * wv.x; acc[4 * j4 + 1] += dv * wv.y; acc[4 * j4 + 2] += dv * wv.z; acc[4 * j4 + 3] += dv * wv.w; } }
        const float* ps = a.pool_scale + (size_t)l * PWID + 64 * g + 16 * q;
        v4u o0, o1;
        o0.x = pk2(acc[0] * ps[0], acc[1] * ps[1]); o0.y = pk2(acc[2] * ps[2], acc[3] * ps[3]); o0.z = pk2(acc[4] * ps[4], acc[5] * ps[5]); o0.w = pk2(acc[6] * ps[6], acc[7] * ps[7]);
        o1.x = pk2(acc[8] * ps[8], acc[9] * ps[9]); o1.y = pk2(acc[10] * ps[10], acc[11] * ps[11]); o1.z = pk2(acc[12] * ps[12], acc[13] * ps[13]); o1.w = pk2(acc[14] * ps[14], acc[15] * ps[15]);
        v4u* dst = (v4u*)(MX + (size_t)(row0 + t) * DM + 384 + 64 * g + 16 * q); dst[0] = o0; dst[1] = o1;
    }
    __syncthreads();
}
__device__ __forceinline__ void mix_conv(const Args& a, int l, int ck, int hc, LAS unsigned char* lds) {
    const int tid = fresh_tid(), lane = tid & 63, wave = __builtin_amdgcn_readfirstlane(tid >> 6);
    const bf16* P = (const bf16*)(a.ws + WS_R1); bf16* MX = (bf16*)(a.ws + WS_MIX);
    LAS float* zt = (LAS float*)lds;
    const int row0 = ck * CHUNK; const bool first = (ck % (SEQ / CHUNK)) == 0;
    const int t = tid >> 2, q = tid & 3, cb = 64 * hc + 16 * q;
    float z[16];
    {   const v4u* sx = (const v4u*)(P + (size_t)(row0 + t) * PW + PC_XA + cb); const v4u* sg = (const v4u*)(P + (size_t)(row0 + t) * PW + PC_GC + cb);
        const v4u x0 = sx[0], x1 = sx[1], g0 = sg[0], g1 = sg[1]; float fx[16], fg[16]; UNPACK8(x0, fx, 0); UNPACK8(x1, fx, 8); UNPACK8(g0, fg, 0); UNPACK8(g1, fg, 8);
#pragma unroll
        for (int j = 0; j < 16; ++j) { z[j] = fx[j] * fg[j]; zt[(2 + t) * 64 + 16 * q + j] = z[j]; }
        if (tid < 8) {
            float hz[16];
            if (first) {
#pragma unroll
                for (int j = 0; j < 16; ++j) hz[j] = 0.f;
            } else { const v4u* hx = (const v4u*)(P + (size_t)(row0 - 2 + t) * PW + PC_XA + cb); const v4u* hg = (const v4u*)(P + (size_t)(row0 - 2 + t) * PW + PC_GC + cb);
                const v4u a0 = hx[0], a1 = hx[1], b0 = hg[0], b1 = hg[1]; float hx_[16], hg_[16]; UNPACK8(a0, hx_, 0); UNPACK8(a1, hx_, 8); UNPACK8(b0, hg_, 0); UNPACK8(b1, hg_, 8);
#pragma unroll
                for (int j = 0; j < 16; ++j) hz[j] = hx_[j] * hg_[j]; }
#pragma unroll
            for (int j = 0; j < 16; ++j) zt[t * 64 + 16 * q + j] = hz[j];
        }
    }
    __syncthreads();
    {   const float* wc = a.w_conv + (size_t)l * 3 * CW + cb;
        const v4u* sb = (const v4u*)(P + (size_t)(row0 + t) * PW + PC_GB + cb); const v4u b0 = sb[0], b1 = sb[1]; float fb[16]; UNPACK8(b0, fb, 0); UNPACK8(b1, fb, 8);
        float y[16];
#pragma unroll
        for (int j = 0; j < 16; ++j) y[j] = fb[j] * (wc[j] * zt[t * 64 + 16 * q + j] + wc[CW + j] * zt[(t + 1) * 64 + 16 * q + j] + wc[2 * CW + j] * z[j]);
        v4u o0, o1;
        o0.x = pk2(y[0], y[1]); o0.y = pk2(y[2], y[3]); o0.z = pk2(y[4], y[5]); o0.w = pk2(y[6], y[7]);
        o1.x = pk2(y[8], y[9]); o1.y = pk2(y[10], y[11]); o1.z = pk2(y[12], y[13]); o1.w = pk2(y[14], y[15]);
        v4u* dst = (v4u*)(MX + (size_t)(row0 + t) * DM + cb); dst[0] = o0; dst[1] = o1;
    }
    __syncthreads();
}

__global__ void __launch_bounds__(NTHR, 2) fwd_mega(Args a) {
    extern __shared__ __attribute__((aligned(16))) unsigned char lds_raw[];
    cg::grid_group grid = cg::this_grid();
    LAS unsigned char* lds = (LAS unsigned char*)lds_raw;
    const int G = gridDim.x, bx = blockIdx.x;
    bf16* Wb = (bf16*)(a.ws + WS_W); bf16* AB = (bf16*)(a.ws + WS_AB); bf16* MX = (bf16*)(a.ws + WS_MIX);
    float* Y = (float*)(a.ws + WS_Y); bf16* PR = (bf16*)(a.ws + WS_R1); bf16* HH = (bf16*)(a.ws + WS_R1);

    convert_layer(a, 0, lds, G, bx);
    cvt_rows(a.x, AB, G, bx);
    grid.sync();

    for (int l = 0; l < DEPTH; ++l) {
        {   pg8::Gemm g{AB, Wb + WOFF_IN, M, PW, DM}; pg8::StaticOrder S; S.init(M, PW, G, bx);
            EpiProj E{PR, PW, 3};
            pg8::gemm_phase<EpiProj, pg8::StaticOrder, true, true>(lds, g, S, E); }
        grid.sync();
        for (int it = bx; it < 128 * 16; it += G) {
            const int part = it >> 7, ck = it & 127;
            if (part < 6) mix_sgu(a, l, ck, part, lds);
            else if (part < 10) mix_pool(a, l, ck, part - 6, lds);
            else mix_conv(a, l, ck, part - 10, lds);
        }
        grid.sync();
        {   pg8::Gemm g{MX, Wb + WOFF_O, M, DM, DM}; pg8::StaticOrder S; S.init(M, DM, G, bx);
            EpiRes E{l == 0 ? a.x : a.out, Y, DM, ALPHA};
            pg8::gemm_phase<EpiRes, pg8::StaticOrder, true, true>(lds, g, S, E); }
        grid.sync();
        ln_rows(Y, a.ln1_g + (size_t)l * DM, a.ln1_b + (size_t)l * DM, Y, AB, G, bx);
        grid.sync();
        {   pg8::Gemm g{AB, Wb + WOFF_GU, M, 2 * DFF, DM}; pg8::StaticOrder S; S.init(M, 2 * DFF, G, bx);
            EpiSwiglu E{HH, DFF};
            pg8::gemm_phase<EpiSwiglu, pg8::StaticOrder, true, true>(lds, g, S, E); }
        grid.sync();
        {   pg8::Gemm g{HH, Wb + WOFF_DN, M, DM, DFF}; pg8::StaticOrder S; S.init(M, DM, G, bx);
            EpiRes E{Y, Y, DM, ALPHA};
            pg8::gemm_phase<EpiRes, pg8::StaticOrder, true, true>(lds, g, S, E); }
        grid.sync();
        ln_rows(Y, a.ln2_g + (size_t)l * DM, a.ln2_b + (size_t)l * DM, a.out, AB, G, bx);
        if (l + 1 < DEPTH) { convert_layer(a, l + 1, lds, G, bx); grid.sync(); }
    }
}

extern "C" void kernel_launch(void* const* d_in, const int* in_sizes, int n_in, void* d_out, int out_size, void* d_ws, size_t ws_size, hipStream_t stream) {
    static int grid = 0;
    if (grid == 0) {
        if (n_in != 15 || ws_size < WS_END) { fprintf(stderr, "kernel_launch: unexpected n_in %d / ws %zu\n", n_in, ws_size); grid = -1; return; }
        int dev = 0, cus = 0, per_cu = 0;
        (void)hipGetDevice(&dev); (void)hipDeviceGetAttribute(&cus, hipDeviceAttributeMultiprocessorCount, dev);
        (void)hipFuncSetAttribute((const void*)fwd_mega, hipFuncAttributeMaxDynamicSharedMemorySize, LDS_BYTES);
        (void)hipOccupancyMaxActiveBlocksPerMultiprocessor(&per_cu, (const void*)fwd_mega, NTHR, LDS_BYTES);
        if (per_cu < 1) { fprintf(stderr, "kernel_launch: occupancy query says %d blocks per CU\n", per_cu); per_cu = 1; }
        (void)hipGetLastError();
        grid = cus;
    }
    if (grid < 0) return;
    Args a{};
    a.x = (const float*)d_in[0]; a.w_in = (const float*)d_in[1]; a.w_conv = (const float*)d_in[2]; a.w_pool = (const float*)d_in[3]; a.pool_scale = (const float*)d_in[4];
    a.sgu_ln_g = (const float*)d_in[5]; a.w_spatial = (const float*)d_in[6]; a.b_spatial = (const float*)d_in[7]; a.w_o = (const float*)d_in[8];
    a.ln1_g = (const float*)d_in[9]; a.ln1_b = (const float*)d_in[10]; a.w_gate_up = (const float*)d_in[11]; a.w_down = (const float*)d_in[12];
    a.ln2_g = (const float*)d_in[13]; a.ln2_b = (const float*)d_in[14];
    a.out = (float*)d_out; a.ws = (unsigned char*)d_ws;
    void* args[] = {&a};
    hipError_t e = hipLaunchCooperativeKernel((const void*)fwd_mega, dim3(grid), dim3(NTHR), args, LDS_BYTES, stream);
    if (e != hipSuccess) fprintf(stderr, "cooperative launch failed: %s (grid %d)\n", hipGetErrorString(e), grid);
}
```

```cpp
#include <hip/hip_runtime.h>
#include <hip/hip_cooperative_groups.h>
#include <cstdio>
#include <cstdint>
namespace pg8 {
#define PG8_LAS __attribute__((address_space(3)))
typedef unsigned short bf16_t;
typedef short bf16x8 __attribute__((ext_vector_type(8)));
typedef float f32x4 __attribute__((ext_vector_type(4)));
typedef unsigned u32x4 __attribute__((ext_vector_type(4)));
constexpr int BM = 256, BK = 64, HALF = 128, HTB = HALF * BK * 2  , STAGE_BYTES = 8 * HTB, NXCD = 8, WGM = 8;

__host__ __device__ __forceinline__ int lds_byte(int r, int c) { const int st = (r >> 4) * 2 + (c >> 5), rr = r & 15, cc = c & 31, ob = rr * 64 + cc * 2; return st * 1024 + (ob ^ (((ob >> 9) & 1) << 5)); }
__host__ __device__ __forceinline__ void stage_rc(int b, int& R, int& C) { const int st = b / 1024, sb = b % 1024, swz = sb ^ (((sb >> 9) & 1) << 5); R = (st >> 1) * 16 + swz / 64; C = (st & 1) * 32 + (swz % 64) / 2; }
__host__ __device__ __forceinline__ int perm32(int rho) { const int n = rho >> 4, i = rho & 15; return 8 * (i >> 2) + 4 * n + (i & 3); }

struct Unit { int pm, pn; };
struct Gemm { const bf16_t* A; const bf16_t* Bt; int M, N, K; };

struct StaticOrder {
    int nM, nN, nwg, G, c;
    __host__ __device__ void init(int M, int N, int G_, int c_) { nM = M / BM; nN = N / BM; nwg = nM * nN; G = G_; c = c_; }
    __host__ __device__ bool next(int i, Unit& u) const {
        const long L = (long)i * G + c; if (L >= nwg) return false;
        int wgid = (int)L; { const int q = nwg / NXCD, r = nwg % NXCD, xcd = wgid % NXCD, off = wgid / NXCD; wgid = (xcd < r ? xcd * (q + 1) : r * (q + 1) + (xcd - r) * q) + off; }
        const int nig = WGM * nN, gid = wgid / nig, fm = gid * WGM, gsz = (nM - fm) < WGM ? (nM - fm) : WGM;
        u.pm = fm + ((wgid % nig) % gsz); u.pn = (wgid % nig) / gsz; return true;
    }
    __device__ __forceinline__ void a_ready(const Unit&) const {}
    __device__ __forceinline__ void done(const Unit&) const {}
};

__device__ __forceinline__ unsigned cvt_pk_bf16(float lo, float hi) { unsigned r; asm volatile("v_cvt_pk_bf16_f32 %0, %1, %2" : "=v"(r) : "v"(lo), "v"(hi)); return r; }
typedef float f32x2 __attribute__((ext_vector_type(2)));
__device__ __forceinline__ f32x2 gelu_pk(f32x2 v) {
    const f32x2 av = __builtin_elementwise_abs(v), d = av * 0.2316418882f + 1.0f;
    f32x2 t; t.x = __builtin_amdgcn_rcpf(d.x); t.y = __builtin_amdgcn_rcpf(d.y);
    f32x2 q = t * 0.5307027145f + (-0.7265760135f); q = q * t + 0.7107068705f; q = q * t + (-0.142248368f); q = q * t + 0.127414796f; q = q * t;
    const f32x2 s = (v * v) * (-0.72134752044f);
    f32x2 e; e.x = __builtin_amdgcn_exp2f(s.x); e.y = __builtin_amdgcn_exp2f(s.y);
    const f32x2 m = v * (q * e), r = v - m;
    f32x2 o; o.x = v.x < 0.f ? m.x : r.x; o.y = v.y < 0.f ? m.y : r.y; return o;
}

template <int ACT  > struct EpiBf16 {
    static constexpr bool PERM = true, AFTER_DRAIN = false; static_assert(ACT == 0 || ACT == 1, "EpiBf16: ACT is 0 (none) or 1 (gelu_pk)");
    bf16_t* O; int ldc; const float* bias; int split_cols; size_t split_stride; float scale0;
    __device__ __forceinline__ void operator()(const f32x4 (&acc)[2][2][4][2], const Unit& u, int wr, int wc, int fr, int fq) const {
        const int row0 = u.pm * BM + wr * 64 + fr; int colt = u.pn * BM; bf16_t* base = O;
        float sc = 1.f; if (split_cols) { const int t = colt / split_cols; base += (size_t)t * split_stride; colt -= t * split_cols; if (t == 0) sc = scale0; }
        const int col0 = colt + wc * 32 + 8 * fq, bcol0 = u.pn * BM + wc * 32 + 8 * fq;
        f32x4 bv[2][2];
#pragma unroll
        for (int bj = 0; bj < 2; ++bj)
#pragma unroll
            for (int n = 0; n < 2; ++n) bv[bj][n] = bias ? *(const f32x4*)(bias + bcol0 + bj * HALF + 4 * n) : (f32x4){0.f, 0.f, 0.f, 0.f};
#pragma unroll
        for (int ai = 0; ai < 2; ++ai)
#pragma unroll
            for (int m = 0; m < 4; ++m) { bf16_t* rowp = base + (size_t)(row0 + ai * HALF + m * 16) * ldc + col0;
#pragma unroll
                for (int bj = 0; bj < 2; ++bj) { f32x4 v0 = acc[ai][bj][m][0] + bv[bj][0], v1 = acc[ai][bj][m][1] + bv[bj][1];
                    if (ACT == 1) { f32x2 a = gelu_pk((f32x2){v0[0], v0[1]}), b = gelu_pk((f32x2){v0[2], v0[3]}), c = gelu_pk((f32x2){v1[0], v1[1]}), d = gelu_pk((f32x2){v1[2], v1[3]});
                        v0 = (f32x4){a.x, a.y, b.x, b.y}; v1 = (f32x4){c.x, c.y, d.x, d.y}; }
                    v0 = v0 * sc; v1 = v1 * sc; u32x4 w; w.x = cvt_pk_bf16(v0[0], v0[1]); w.y = cvt_pk_bf16(v0[2], v0[3]); w.z = cvt_pk_bf16(v1[0], v1[1]); w.w = cvt_pk_bf16(v1[2], v1[3]);
                    *(u32x4*)(rowp + bj * HALF) = w; } }
    }
};

struct PanelStats {
    unsigned* xbuf;
    unsigned* cnt;
    unsigned* tmo;
    int ntn; float eps;
    unsigned code;
    __device__ __forceinline__ bool run(const f32x4 (&v)[2][2][4][2], const Unit& u, int wr, int wc, int fr, int fq, PG8_LAS unsigned char* lds, int wid, int lane) const {
        typedef float f32x2v __attribute__((ext_vector_type(2)));
        PG8_LAS f32x2v* P = (PG8_LAS f32x2v*)lds;
        PG8_LAS f32x2v* S = (PG8_LAS f32x2v*)(lds + 8192);
        PG8_LAS unsigned* flag = (PG8_LAS unsigned*)(lds + 8192 + 2048);
#pragma unroll
        for (int ai = 0; ai < 2; ++ai)
#pragma unroll
            for (int m = 0; m < 4; ++m) {
                float s = 0.f;
#pragma unroll
                for (int bj = 0; bj < 2; ++bj)
#pragma unroll
                    for (int n = 0; n < 2; ++n) { const f32x4 x = v[ai][bj][m][n]; s += (x[0] + x[1]) + (x[2] + x[3]); }
                s += __shfl_xor(s, 16); s += __shfl_xor(s, 32);
                const float mw = s * (1.0f / 64.0f); float q = 0.f;
#pragma unroll
                for (int bj = 0; bj < 2; ++bj)
#pragma unroll
                    for (int n = 0; n < 2; ++n) { const f32x4 d = v[ai][bj][m][n] - mw; q += (d[0] * d[0] + d[1] * d[1]) + (d[2] * d[2] + d[3] * d[3]); }
                q += __shfl_xor(q, 16); q += __shfl_xor(q, 32);
                if (fq == 0) P[(ai * HALF + wr * 64 + m * 16 + fr) * 4 + wc] = (f32x2v){mw, q};
            }
        asm volatile("s_waitcnt lgkmcnt(0)" ::: "memory"); __builtin_amdgcn_s_barrier(); asm volatile("" ::: "memory");
#if defined(BROKEN_EXCHANGE_NO_WAIT)
#warning BROKEN CONTROL BUILD: the row-statistics exchange does not wait; results are wrong by design
        if (blockIdx.x >= 64) { const long long t0_ = clock64(); while (clock64() - t0_ < 60000) __builtin_amdgcn_s_sleep(8); }
#endif
        const int row = wid * 32 + (lane & 31);
        if (lane < 32) {
            const f32x2v a = P[row * 4 + 0], b = P[row * 4 + 1], c = P[row * 4 + 2], d = P[row * 4 + 3];
            const float mt = (a.x + b.x + c.x + d.x) * 0.25f;
            const float da = a.x - mt, db = b.x - mt, dc = c.x - mt, dd = d.x - mt;
            const float m2 = (a.y + b.y) + (c.y + d.y) + 64.0f * ((da * da + db * db) + (dc * dc + dd * dd));
            unsigned long long* slot = (unsigned long long*)xbuf + ((size_t)(u.pm * BM + row) * 4 + u.pn);
            __hip_atomic_store(slot, ((unsigned long long)__float_as_uint(m2) << 32) | __float_as_uint(mt), __ATOMIC_RELAXED, __HIP_MEMORY_SCOPE_AGENT);
        }
        asm volatile("s_waitcnt vmcnt(0)" ::: "memory");
        if (lane == 0) __hip_atomic_fetch_add(cnt + 64 * u.pm, 1u, __ATOMIC_RELAXED, __HIP_MEMORY_SCOPE_AGENT);
        if (wid == 0) {
            bool dead = false; const unsigned long long t0 = __builtin_amdgcn_s_memrealtime(); const unsigned want = 8u * (unsigned)ntn;
            for (;;) {
#if defined(BROKEN_EXCHANGE_NO_WAIT)
                break;
#endif
                if ((unsigned)__builtin_amdgcn_readfirstlane(__hip_atomic_load(cnt + 64 * u.pm, __ATOMIC_RELAXED, __HIP_MEMORY_SCOPE_AGENT)) >= want) break;
                if (__builtin_amdgcn_s_memrealtime() - t0 > 2000000ull) {
                    if (lane == 0) { unsigned expect = 0u; __hip_atomic_compare_exchange_strong(tmo + 1, &expect, code | (unsigned)(u.pm & 0xff), __ATOMIC_RELAXED, __ATOMIC_RELAXED, __HIP_MEMORY_SCOPE_AGENT);
                                     __hip_atomic_store(tmo, 1u, __ATOMIC_RELAXED, __HIP_MEMORY_SCOPE_AGENT); }
                    dead = true; break; }
                __builtin_amdgcn_s_sleep(2);
            }
            __builtin_amdgcn_fence(__ATOMIC_ACQUIRE, "agent");
            if (lane == 0) flag[0] = dead ? 1u : 0u;
        }
        asm volatile("s_waitcnt vmcnt(0) lgkmcnt(0)" ::: "memory"); __builtin_amdgcn_s_barrier(); asm volatile("" ::: "memory");
        const bool bad = flag[0] != 0u;
        if (lane < 32) {
            const unsigned long long* slot = (const unsigned long long*)xbuf + (size_t)(u.pm * BM + row) * 4; float mt[4], m2[4]; float ms = 0.f;
#pragma unroll
            for (int t = 0; t < 4; ++t) { if (t < ntn) { const unsigned long long w = __hip_atomic_load(slot + t, __ATOMIC_RELAXED, __HIP_MEMORY_SCOPE_AGENT); mt[t] = __uint_as_float((unsigned)w); m2[t] = __uint_as_float((unsigned)(w >> 32)); } else { mt[t] = 0.f; m2[t] = 0.f; } ms += mt[t]; }
            const float mean = ms / (float)ntn; float q = 0.f;
#pragma unroll
            for (int t = 0; t < 4; ++t) if (t < ntn) { const float dm = mt[t] - mean; q += m2[t] + 256.0f * dm * dm; }
            S[row] = (f32x2v){mean, 1.0f / sqrtf(q / (256.0f * (float)ntn) + eps)};
        }
        asm volatile("s_waitcnt lgkmcnt(0)" ::: "memory"); __builtin_amdgcn_s_barrier(); asm volatile("" ::: "memory");
        return bad;
    }
};
struct EpiLnRes {
    static constexpr bool PERM = false, AFTER_DRAIN = true;
    const float* base; float* out; int ldc; const float* bias; PanelStats st; unsigned poison;
    __device__ __forceinline__ void fused(f32x4 (&acc)[2][2][4][2], const Unit& u, int wr, int wc, int fr, int fq, PG8_LAS unsigned char* lds, int wid, int lane) const {
        typedef float f32x2v __attribute__((ext_vector_type(2)));
        const PG8_LAS f32x2v* S = (const PG8_LAS f32x2v*)(lds + 8192);
        const int col0 = u.pn * BM + wc * 32 + 4 * fq;
#pragma unroll
        for (int bj = 0; bj < 2; ++bj)
#pragma unroll
            for (int n = 0; n < 2; ++n) { const f32x4 bv = bias ? *(const f32x4*)(bias + col0 + bj * HALF + n * 16) : (f32x4){0.f, 0.f, 0.f, 0.f};
#pragma unroll
                for (int ai = 0; ai < 2; ++ai)
#pragma unroll
                    for (int m = 0; m < 4; ++m) acc[ai][bj][m][n] += bv; }
        f32x4 pre[4][2][2];
#pragma unroll
        for (int m = 0; m < 4; ++m) { const size_t off = (size_t)(u.pm * BM + wr * 64 + m * 16 + fr) * ldc + col0;
#pragma unroll
            for (int bj = 0; bj < 2; ++bj)
#pragma unroll
                for (int n = 0; n < 2; ++n) pre[m][bj][n] = *(const f32x4*)(base + off + bj * HALF + n * 16); }
        const bool bad = st.run(acc, u, wr, wc, fr, fq, lds, wid, lane) || poison != 0u;
        const float qnan = __builtin_nanf("");
#pragma unroll
        for (int ai = 0; ai < 2; ++ai)
#pragma unroll
            for (int m = 0; m < 4; ++m) { const int r = ai * HALF + wr * 64 + m * 16 + fr; const f32x2v sr = S[r]; const size_t off = (size_t)(u.pm * BM + r) * ldc + col0;
#pragma unroll
                for (int bj = 0; bj < 2; ++bj)
#pragma unroll
                    for (int n = 0; n < 2; ++n) { const f32x4 bs = ai == 0 ? pre[m][bj][n] : *(const f32x4*)(base + off + bj * HALF + n * 16); f32x4 o = bs + (acc[ai][bj][m][n] - sr.x) * sr.y;
                        if (bad) o = (f32x4){qnan, qnan, qnan, qnan}; *(f32x4*)(out + off + bj * HALF + n * 16) = o; }
                if (m & 1) asm volatile("" ::: "memory"); }
    }
};
struct EpiLnResLn {
    static constexpr bool PERM = false, AFTER_DRAIN = true;
    const float* base; float* out; bf16_t* xn; int ldc; const float* bias; PanelStats st1, st2; unsigned poison;
    __device__ __forceinline__ void fused(f32x4 (&acc)[2][2][4][2], const Unit& u, int wr, int wc, int fr, int fq, PG8_LAS unsigned char* lds, int wid, int lane) const {
        typedef float f32x2v __attribute__((ext_vector_type(2))); typedef unsigned u32x2v __attribute__((ext_vector_type(2)));
        const PG8_LAS f32x2v* S = (const PG8_LAS f32x2v*)(lds + 8192);
        const int col0 = u.pn * BM + wc * 32 + 4 * fq;
#pragma unroll
        for (int bj = 0; bj < 2; ++bj)
#pragma unroll
            for (int n = 0; n < 2; ++n) { const f32x4 bv = bias ? *(const f32x4*)(bias + col0 + bj * HALF + n * 16) : (f32x4){0.f, 0.f, 0.f, 0.f};
#pragma unroll
                for (int ai = 0; ai < 2; ++ai)
#pragma unroll
                    for (int m = 0; m < 4; ++m) acc[ai][bj][m][n] += bv; }
        bool bad = st1.run(acc, u, wr, wc, fr, fq, lds, wid, lane) || poison != 0u;
        const float qnan = __builtin_nanf("");
#pragma unroll
        for (int ai = 0; ai < 2; ++ai)
#pragma unroll
            for (int m = 0; m < 4; ++m) { const int r = ai * HALF + wr * 64 + m * 16 + fr; const f32x2v sr = S[r]; const size_t off = (size_t)(u.pm * BM + r) * ldc + col0;
#pragma unroll
                for (int bj = 0; bj < 2; ++bj)
#pragma unroll
                    for (int n = 0; n < 2; ++n) { const f32x4 bs = *(const f32x4*)(base + off + bj * HALF + n * 16); acc[ai][bj][m][n] = bs + (acc[ai][bj][m][n] - sr.x) * sr.y; }
                asm volatile("" : "+v"(acc[ai][0][m][0]), "+v"(acc[ai][0][m][1]), "+v"(acc[ai][1][m][0]), "+v"(acc[ai][1][m][1]));
                if (m & 1) asm volatile("" ::: "memory"); }
        const bool bad1 = bad;
        bad = st2.run(acc, u, wr, wc, fr, fq, lds, wid, lane) || bad;
#pragma unroll
        for (int ai = 0; ai < 2; ++ai)
#pragma unroll
            for (int m = 0; m < 4; ++m) { const int r = ai * HALF + wr * 64 + m * 16 + fr; const f32x2v sr = S[r]; const size_t off = (size_t)(u.pm * BM + r) * ldc + col0;
#pragma unroll
                for (int bj = 0; bj < 2; ++bj)
#pragma unroll
                    for (int n = 0; n < 2; ++n) { const f32x4 x1 = acc[ai][bj][m][n]; *(f32x4*)(out + off + bj * HALF + n * 16) = bad1 ? (f32x4){qnan, qnan, qnan, qnan} : x1;
                        const f32x4 o = (x1 - sr.x) * sr.y; u32x2v w; w.x = cvt_pk_bf16(o[0], o[1]); w.y = cvt_pk_bf16(o[2], o[3]);
                        if (bad) { w.x = 0x7fc07fc0u; w.y = 0x7fc07fc0u; } *(u32x2v*)(xn + off + bj * HALF + n * 16) = w; }
                asm volatile("" ::: "memory"); }
    }
};

template <class Epi, class Sched, bool ALIGN_EPI = false, bool SP2 = false>
__device__ __forceinline__ void gemm_phase(PG8_LAS unsigned char* lds, const Gemm g, const Sched& S, const Epi& E) {
    int tid_ = threadIdx.x; asm volatile("" : "+v"(tid_));
    const int tid = tid_, wid = __builtin_amdgcn_readfirstlane(tid >> 6), lane = tid & 63, wr = wid >> 2, wc = wid & 3, fr = lane & 15, fq = lane >> 4;
    const int K = g.K, nt = K / BK;
    unsigned voffA[2], voffB[2];
#pragma unroll
    for (int i = 0; i < 2; ++i) { int R, C; stage_rc(tid * 16 + i * 8192, R, C); const int Rb = Epi::PERM ? ((R & ~31) + perm32(R & 31)) : R;
        voffA[i] = (unsigned)(R * K + C) * 2u; voffB[i] = (unsigned)(Rb * K + C) * 2u; }
    const size_t kstep = (size_t)(BK * 2);
    const size_t hstep = (size_t)HALF * K * 2;
    const size_t tstep = 2 * hstep;
    const unsigned ldsw = (unsigned)wid * 1024u;
    const int aoff = lds_byte(wr * 64 + fr, fq * 8), boff = lds_byte(wc * 32 + fr, fq * 8);
#define PG8_SA(b, h) (((b) * 2 + (h)) * HTB)
#define PG8_SB(b, h) ((4 + (b) * 2 + (h)) * HTB)
#define PG8_STAGE(bufoff, gbase, voff) do { _Pragma("unroll") for (int _i = 0; _i < 2; ++_i) \
        __builtin_amdgcn_global_load_lds((const unsigned*)((const char*)(gbase) + (voff)[_i]), (PG8_LAS unsigned*)(lds + (bufoff) + ldsw + _i * 8192), 16, 0, 0); } while (0)
#define PG8_LDA(dst, b, h) do { _Pragma("unroll") for (int m = 0; m < 4; ++m) _Pragma("unroll") for (int k = 0; k < 2; ++k) dst[m][k] = *(const PG8_LAS bf16x8*)(lds + PG8_SA(b, h) + aoff + m * 2048 + k * 1024); } while (0)
#define PG8_LDB(dst, b, h) do { _Pragma("unroll") for (int n = 0; n < 2; ++n) _Pragma("unroll") for (int k = 0; k < 2; ++k) dst[n][k] = *(const PG8_LAS bf16x8*)(lds + PG8_SB(b, h) + boff + n * 2048 + k * 1024); } while (0)
#define PG8_MMA(ai, bj, At, Bt) do { __builtin_amdgcn_s_setprio(1); _Pragma("unroll") for (int m = 0; m < 4; ++m) _Pragma("unroll") for (int n = 0; n < 2; ++n) _Pragma("unroll") for (int k = 0; k < 2; ++k) \
        acc[ai][bj][m][n] = __builtin_amdgcn_mfma_f32_16x16x32_bf16(Bt[n][k], At[m][k], acc[ai][bj][m][n], 0, 0, 0); __builtin_amdgcn_s_setprio(0); } while (0)
#define PG8_WAIT_V(n) asm volatile("s_waitcnt vmcnt(" #n ")" ::: "memory")
#define PG8_WAIT_L(n) asm volatile("s_waitcnt lgkmcnt(" #n ")" ::: "memory")
#define PG8_BAR __builtin_amdgcn_s_barrier()
#define PG8_SCHED __builtin_amdgcn_sched_barrier(0)
    Unit cur, nxt; int ui = 0;
    if (!S.next(0, cur)) return;
    f32x4 acc[2][2][4][2];
#pragma unroll
    for (int a = 0; a < 2; ++a)
#pragma unroll
        for (int b = 0; b < 2; ++b)
#pragma unroll
            for (int m = 0; m < 4; ++m)
#pragma unroll
                for (int n = 0; n < 2; ++n) acc[a][b][m][n] = (f32x4){0.f, 0.f, 0.f, 0.f};
    bf16x8 At[4][2], B0[2][2], B1[2][2];
    const char* cA = (const char*)g.A + (size_t)cur.pm * tstep; const char* cB = (const char*)g.Bt + (size_t)cur.pn * tstep;
    S.a_ready(cur);
    if constexpr (SP2) {
        PG8_STAGE(PG8_SB(0, 0), cB, voffB); PG8_STAGE(PG8_SB(0, 1), cB + hstep, voffB); PG8_STAGE(PG8_SA(0, 0), cA, voffA); PG8_STAGE(PG8_SA(0, 1), cA + hstep, voffA);
        if (wr == 1) PG8_BAR;
        PG8_WAIT_V(2); PG8_BAR;
        PG8_STAGE(PG8_SB(1, 0), cB + kstep, voffB); PG8_STAGE(PG8_SA(1, 0), cA + kstep, voffA); PG8_STAGE(PG8_SB(1, 1), cB + hstep + kstep, voffB);
        PG8_WAIT_V(6); PG8_BAR;
    } else {
        PG8_STAGE(PG8_SB(0, 0), cB, voffB); PG8_STAGE(PG8_SA(0, 0), cA, voffA); PG8_STAGE(PG8_SB(0, 1), cB + hstep, voffB); PG8_STAGE(PG8_SA(0, 1), cA + hstep, voffA);
        if (wr == 1) PG8_BAR;
        PG8_WAIT_V(4); PG8_BAR;
        PG8_STAGE(PG8_SB(1, 0), cB + kstep, voffB); PG8_STAGE(PG8_SA(1, 0), cA + kstep, voffA); PG8_STAGE(PG8_SB(1, 1), cB + hstep + kstep, voffB);
        PG8_WAIT_V(6); PG8_BAR;
    }
    for (;;) {
        const bool has_next = S.next(ui + 1, nxt);
        const char* nA = has_next ? (const char*)g.A + (size_t)nxt.pm * tstep : cA; const char* nB = has_next ? (const char*)g.Bt + (size_t)nxt.pn * tstep : cB;
        for (int t = 0; t < nt; t += 2) {
            const bool last = (t == nt - 2);
            const char* a1 = cA + (size_t)(t + 1) * kstep;
            const char* a2 = last ? nA : cA + (size_t)(t + 2) * kstep; const char* b2 = last ? nB : cB + (size_t)(t + 2) * kstep;
            const char* a3 = a2 + kstep; const char* b3 = b2 + kstep;
            if (last && has_next) S.a_ready(nxt);
            if constexpr (SP2) {
            PG8_LDB(B0, 0, 0); PG8_LDB(B1, 0, 1); PG8_SCHED; PG8_LDA(At, 0, 0); PG8_STAGE(PG8_SA(1, 1), a1 + hstep, voffA);
            PG8_WAIT_V(8); PG8_WAIT_L(0); PG8_BAR; PG8_MMA(0, 0, At, B0); PG8_MMA(0, 1, At, B1); PG8_BAR; PG8_SCHED;
            PG8_LDA(At, 0, 1); PG8_STAGE(PG8_SB(0, 0), b2, voffB); PG8_STAGE(PG8_SB(0, 1), b2 + hstep, voffB); PG8_STAGE(PG8_SA(0, 0), a2, voffA);
            PG8_WAIT_V(8); PG8_WAIT_L(0); PG8_BAR; PG8_MMA(1, 0, At, B0); PG8_MMA(1, 1, At, B1); PG8_BAR; PG8_SCHED;
            PG8_LDB(B0, 1, 0); PG8_LDB(B1, 1, 1); PG8_SCHED; PG8_LDA(At, 1, 0); PG8_STAGE(PG8_SA(0, 1), a2 + hstep, voffA);
            PG8_WAIT_V(8); PG8_WAIT_L(0); PG8_BAR; PG8_MMA(0, 0, At, B0); PG8_MMA(0, 1, At, B1); PG8_BAR; PG8_SCHED;
            PG8_LDA(At, 1, 1); PG8_STAGE(PG8_SB(1, 0), b3, voffB); PG8_STAGE(PG8_SB(1, 1), b3 + hstep, voffB); PG8_STAGE(PG8_SA(1, 0), a3, voffA);
            PG8_WAIT_V(8); PG8_WAIT_L(0); PG8_BAR; PG8_MMA(1, 0, At, B0); PG8_MMA(1, 1, At, B1); PG8_BAR; PG8_SCHED;
            } else {
            PG8_LDB(B0, 0, 0); PG8_SCHED; PG8_LDA(At, 0, 0); PG8_STAGE(PG8_SA(1, 1), a1 + hstep, voffA);
            PG8_WAIT_L(8); PG8_BAR; PG8_WAIT_L(0); PG8_MMA(0, 0, At, B0); PG8_BAR; PG8_SCHED;
            PG8_LDB(B1, 0, 1); PG8_STAGE(PG8_SB(0, 0), b2, voffB);
            PG8_BAR; PG8_WAIT_L(0); PG8_MMA(0, 1, At, B1); PG8_BAR;
            PG8_LDA(At, 0, 1); PG8_STAGE(PG8_SA(0, 0), a2, voffA);
            PG8_BAR; PG8_WAIT_L(0); PG8_MMA(1, 0, At, B0); PG8_BAR; PG8_SCHED;
            PG8_STAGE(PG8_SB(0, 1), b2 + hstep, voffB);
            PG8_WAIT_V(6); PG8_BAR; PG8_MMA(1, 1, At, B1); PG8_BAR;
            PG8_LDB(B0, 1, 0); PG8_SCHED; PG8_LDA(At, 1, 0); PG8_STAGE(PG8_SA(0, 1), a2 + hstep, voffA);
            PG8_WAIT_L(8); PG8_BAR; PG8_WAIT_L(0); PG8_MMA(0, 0, At, B0); PG8_BAR; PG8_SCHED;
            PG8_LDB(B1, 1, 1); PG8_STAGE(PG8_SB(1, 0), b3, voffB);
            PG8_BAR; PG8_WAIT_L(0); PG8_MMA(0, 1, At, B1); PG8_BAR;
            PG8_LDA(At, 1, 1); PG8_STAGE(PG8_SA(1, 0), a3, voffA);
            PG8_BAR; PG8_WAIT_L(0); PG8_MMA(1, 0, At, B0); PG8_BAR; PG8_SCHED;
            PG8_STAGE(PG8_SB(1, 1), b3 + hstep, voffB);
            PG8_WAIT_V(6); PG8_BAR; PG8_MMA(1, 1, At, B1); PG8_BAR;
            }
        }
        if constexpr (ALIGN_EPI) { if (wr == 0) PG8_BAR; }
        if constexpr (!Epi::AFTER_DRAIN) { E(acc, cur, wr, wc, fr, fq); S.done(cur); }
        if (!has_next) break;
#pragma unroll
        for (int a = 0; a < 2; ++a)
#pragma unroll
            for (int b = 0; b < 2; ++b)
#pragma unroll
                for (int m = 0; m < 4; ++m)
#pragma unroll
                    for (int n = 0; n < 2; ++n) acc[a][b][m][n] = (f32x4){0.f, 0.f, 0.f, 0.f};
        cur = nxt; cA = nA; cB = nB; ++ui;
        if constexpr (ALIGN_EPI) { if (wr == 1) PG8_BAR; }
    }
    PG8_WAIT_V(0);
    if constexpr (!ALIGN_EPI) { if (wr == 0) PG8_BAR; }
    PG8_BAR;
    if constexpr (Epi::AFTER_DRAIN) { E.fused(acc, cur, wr, wc, fr, fq, lds, wid, lane); S.done(cur); }
#undef PG8_SA
#undef PG8_SB
#undef PG8_STAGE
#undef PG8_LDA
#undef PG8_LDB
#undef PG8_MMA
#undef PG8_WAIT_V
#undef PG8_WAIT_L
#undef PG8_BAR
#undef PG8_SCHED
}
}

namespace cg = cooperative_groups;
#define LAS __attribute__((address_space(3)))
typedef unsigned short bf16;
typedef unsigned v4u __attribute__((ext_vector_type(4)));
typedef float f32x4 __attribute__((ext_vector_type(4)));
typedef const __attribute__((address_space(4))) float cfloat;

constexpr int NWAVES = 8, NTHR = 512;
constexpr int DM = 1024, BATCH = 8, SEQ = 2048, DEPTH = 4, M = BATCH * SEQ;
constexpr int CW = 384, PWID = 256, SW = 384, INW = 2176, PW = 2304  , DFF = 2816, CHUNK = 128;
constexpr float LN_EPS = 1e-5f;
constexpr float ALPHA = 1.681792830507429f;
constexpr int PC_U = 0, PC_V = 384, PC_XA = 768, PC_GB = 1152, PC_GC = 1536, PC_P = 1920;
constexpr size_t MiB = 1u << 20;
constexpr size_t WS_W = 1 * MiB, WS_AB = 24 * MiB, WS_MIX = 56 * MiB, WS_Y = 88 * MiB, WS_R1 = 152 * MiB, WS_END = 240 * MiB;
constexpr size_t WOFF_IN = 0, WOFF_O = (size_t)PW * DM, WOFF_GU = WOFF_O + (size_t)DM * DM, WOFF_DN = WOFF_GU + (size_t)2 * DFF * DM;
static_assert((WOFF_DN + (size_t)DM * DFF) * 2 + WS_W <= WS_AB, "weights fit");
constexpr int LDS_BYTES = 147456;

__device__ __forceinline__ unsigned f2bf(float f) { unsigned u = __builtin_bit_cast(unsigned, f); return (u + 0x7fffu + ((u >> 16) & 1u)) >> 16; }
__device__ __forceinline__ unsigned pk2(float lo, float hi) { return f2bf(lo) | (f2bf(hi) << 16); }
__device__ __forceinline__ float bflo(unsigned w) { return __builtin_bit_cast(float, w << 16); }
__device__ __forceinline__ float bfhi(unsigned w) { return __builtin_bit_cast(float, w & 0xffff0000u); }
__device__ __forceinline__ float wave_sum(float v) {
#pragma unroll
    for (int o = 1; o < 64; o <<= 1) v += __shfl_xor(v, o);
    return v;
}
#define UNPACK8(V_, f, o) do { f[o+0] = bflo((V_).x); f[o+1] = bfhi((V_).x); f[o+2] = bflo((V_).y); f[o+3] = bfhi((V_).y); f[o+4] = bflo((V_).z); f[o+5] = bfhi((V_).z); f[o+6] = bflo((V_).w); f[o+7] = bfhi((V_).w); } while (0)

__device__ __forceinline__ int fresh_tid() { int t = threadIdx.x; asm volatile("" : "+v"(t)); return t; }
struct Args {
    const float *x, *w_in, *w_conv, *w_pool, *pool_scale, *sgu_ln_g, *w_spatial, *b_spatial, *w_o, *ln1_g, *ln1_b, *w_gate_up, *w_down, *ln2_g, *ln2_b;
    float* out; unsigned char* ws;
};

struct EpiProj {
    static constexpr bool PERM = true, AFTER_DRAIN = false;
    bf16* O; int ldc; int gelu_tiles;
    __device__ __forceinline__ void operator()(const pg8::f32x4 (&acc)[2][2][4][2], const pg8::Unit& u, int wr, int wc, int fr, int fq) const {
        using namespace pg8;
        const int row0 = u.pm * BM + wr * 64 + fr, col0 = u.pn * BM + wc * 32 + 8 * fq;
        const bool act = u.pn < gelu_tiles;
#pragma unroll
        for (int ai = 0; ai < 2; ++ai)
#pragma unroll
            for (int m = 0; m < 4; ++m) { bf16* rowp = O + (size_t)(row0 + ai * HALF + m * 16) * ldc + col0;
#pragma unroll
                for (int bj = 0; bj < 2; ++bj) { pg8::f32x4 v0 = acc[ai][bj][m][0], v1 = acc[ai][bj][m][1];
                    if (act) { f32x2 a = gelu_pk((f32x2){v0[0], v0[1]}), b = gelu_pk((f32x2){v0[2], v0[3]}), c = gelu_pk((f32x2){v1[0], v1[1]}), d = gelu_pk((f32x2){v1[2], v1[3]});
                        v0 = (pg8::f32x4){a.x, a.y, b.x, b.y}; v1 = (pg8::f32x4){c.x, c.y, d.x, d.y}; }
                    u32x4 w; w.x = cvt_pk_bf16(v0[0], v0[1]); w.y = cvt_pk_bf16(v0[2], v0[3]); w.z = cvt_pk_bf16(v1[0], v1[1]); w.w = cvt_pk_bf16(v1[2], v1[3]);
                    *(u32x4*)(rowp + bj * HALF) = w; } }
    }
};
struct EpiRes {
    static constexpr bool PERM = false, AFTER_DRAIN = false;
    const float* X; float* Y; int ldc; float alpha;
    __device__ __forceinline__ void operator()(const pg8::f32x4 (&acc)[2][2][4][2], const pg8::Unit& u, int wr, int wc, int fr, int fq) const {
        using namespace pg8;
        const int row0 = u.pm * BM + wr * 64 + fr, col0 = u.pn * BM + wc * 32 + 4 * fq;
#pragma unroll
        for (int ai = 0; ai < 2; ++ai)
#pragma unroll
            for (int m = 0; m < 4; ++m) { const size_t off = (size_t)(row0 + ai * HALF + m * 16) * ldc + col0;
#pragma unroll
                for (int bj = 0; bj < 2; ++bj)
#pragma unroll
                    for (int n = 0; n < 2; ++n) { const pg8::f32x4 xv = *(const pg8::f32x4*)(X + off + bj * HALF + n * 16);
                        *(pg8::f32x4*)(Y + off + bj * HALF + n * 16) = xv * alpha + acc[ai][bj][m][n]; }
                asm volatile("" ::: "memory"); }
    }
};
struct EpiSwiglu {
    static constexpr bool PERM = true, AFTER_DRAIN = false;
    bf16* H; int ldc;
    __device__ __forceinline__ void operator()(const pg8::f32x4 (&acc)[2][2][4][2], const pg8::Unit& u, int wr, int wc, int fr, int fq) const {
        using namespace pg8;
        const int row0 = u.pm * BM + wr * 64 + fr, col0 = u.pn * HALF + wc * 32 + 8 * fq;
#pragma unroll
        for (int ai = 0; ai < 2; ++ai)
#pragma unroll
            for (int m = 0; m < 4; ++m) { bf16* rowp = H + (size_t)(row0 + ai * HALF + m * 16) * ldc + col0;
                float h[8];
#pragma unroll
                for (int n = 0; n < 2; ++n)
#pragma unroll
                    for (int j = 0; j < 4; ++j) { const float g = acc[ai][0][m][n][j], uu = acc[ai][1][m][n][j];
                        const float s = __builtin_amdgcn_rcpf(1.0f + __builtin_amdgcn_exp2f(g * -1.4426950408889634f)); h[n * 4 + j] = g * s * uu; }
                u32x4 w; w.x = cvt_pk_bf16(h[0], h[1]); w.y = cvt_pk_bf16(h[2], h[3]); w.z = cvt_pk_bf16(h[4], h[5]); w.w = cvt_pk_bf16(h[6], h[7]);
                *(u32x4*)rowp = w; }
    }
};

__device__ __forceinline__ void transpose_item(const float* W, int K, int N, bf16* WT, int k0, int n0, int drow0, LAS float* scr, int lane) {
#pragma unroll 8
    for (int i = 0; i < 32; ++i) { const int kk = 2 * i + (lane >> 5); scr[kk * 33 + (lane & 31)] = W[(size_t)(k0 + kk) * N + n0 + (lane & 31)]; }
    asm volatile("s_waitcnt lgkmcnt(0)" ::: "memory");
    const int c = lane & 7;
#pragma unroll
    for (int j = 0; j < 4; ++j) { const int n = (lane >> 3) + 8 * j; const LAS float* s = scr + (8 * c) * 33 + n;
        v4u o; o.x = pk2(s[0 * 33], s[1 * 33]); o.y = pk2(s[2 * 33], s[3 * 33]); o.z = pk2(s[4 * 33], s[5 * 33]); o.w = pk2(s[6 * 33], s[7 * 33]);
        *(v4u*)(WT + (size_t)(drow0 + n) * K + k0 + 8 * c) = o; }
    asm volatile("s_waitcnt lgkmcnt(0)" ::: "memory");
}
__device__ __forceinline__ void convert_layer(const Args& a, int l, LAS unsigned char* lds, int G, int bx) {
    const int tid = fresh_tid(), lane = tid & 63, wave = __builtin_amdgcn_readfirstlane(tid >> 6), gw = bx * NWAVES + wave, NGW = G * NWAVES;
    LAS float* scr = (LAS float*)(lds + wave * 16384);
    bf16* Wb = (bf16*)(a.ws + WS_W);
    constexpr int I_IN = 16 * 68, I_O = 16 * 32, I_GU = 16 * 176, I_DN = 44 * 32, I_PAD = 128;
    constexpr int NIT = I_IN + I_O + I_GU + I_DN + I_PAD;
    for (int it = gw; it < NIT; it += NGW) {
        int r = it;
        if (r < I_IN) { const int kb = r / 68, nb = r % 68, n0 = 32 * nb; const int dr = n0 < 1408 ? n0 + 768 : n0 - 1408;
            transpose_item(a.w_in + (size_t)l * DM * INW, DM, INW, Wb + WOFF_IN, 64 * kb, n0, dr, scr, lane); continue; } r -= I_IN;
        if (r < I_O) { const int kb = r / 32, nb = r % 32; transpose_item(a.w_o + (size_t)l * DM * DM, DM, DM, Wb + WOFF_O, 64 * kb, 32 * nb, 32 * nb, scr, lane); continue; } r -= I_O;
        if (r < I_GU) { const int kb = r / 176, nb = r % 176, n0 = 32 * nb; int dr;
            if (n0 < DFF) dr = 256 * (n0 / 128) + (n0 % 128); else { const int n1 = n0 - DFF; dr = 256 * (n1 / 128) + 128 + (n1 % 128); }
            transpose_item(a.w_gate_up + (size_t)l * DM * 2 * DFF, DM, 2 * DFF, Wb + WOFF_GU, 64 * kb, n0, dr, scr, lane); continue; } r -= I_GU;
        if (r < I_DN) { const int kb = r / 32, nb = r % 32; transpose_item(a.w_down + (size_t)l * DFF * DM, DFF, DM, Wb + WOFF_DN, 64 * kb, 32 * nb, 32 * nb, scr, lane); continue; } r -= I_DN;
        { v4u z = (v4u){0u, 0u, 0u, 0u}; v4u* p = (v4u*)(Wb + WOFF_IN + (size_t)(INW + r) * DM) + lane * 2; p[0] = z; p[1] = z; }
    }
}

__device__ __forceinline__ void ln_rows(const float* Y, const float* g, const float* b, float* of, bf16* ob, int G, int bx) {
    const int tid = fresh_tid(), lane = tid & 63, wave = __builtin_amdgcn_readfirstlane(tid >> 6), gw = bx * NWAVES + wave, NGW = G * NWAVES;
    f32x4 gv[4], bv[4];
#pragma unroll
    for (int j = 0; j < 4; ++j) { gv[j] = ((const f32x4*)g)[lane + 64 * j]; bv[j] = ((const f32x4*)b)[lane + 64 * j]; }
    for (int m = gw; m < M; m += NGW) {
        const f32x4* xr = (const f32x4*)(Y + (size_t)m * DM) + lane;
        f32x4 v[4]; float s = 0.f;
#pragma unroll
        for (int j = 0; j < 4; ++j) { v[j] = xr[64 * j]; s += (v[j].x + v[j].y) + (v[j].z + v[j].w); }
        const float mean = wave_sum(s) * (1.f / DM); float s2 = 0.f;
#pragma unroll
        for (int j = 0; j < 4; ++j) { v[j] = v[j] - mean; s2 += (v[j].x * v[j].x + v[j].y * v[j].y) + (v[j].z * v[j].z + v[j].w * v[j].w); }
        const float rstd = 1.f / sqrtf(wave_sum(s2) * (1.f / DM) + LN_EPS);
        f32x4* o4 = (f32x4*)(of + (size_t)m * DM) + lane;
        unsigned long long* o8 = (unsigned long long*)(ob + (size_t)m * DM) + lane;
#pragma unroll
        for (int j = 0; j < 4; ++j) { const f32x4 o = v[j] * rstd * gv[j] + bv[j]; o4[64 * j] = o;
            o8[64 * j] = (unsigned long long)pk2(o.x, o.y) | ((unsigned long long)pk2(o.z, o.w) << 32); }
    }
}
__device__ __forceinline__ void cvt_rows(const float* X, bf16* ob, int G, int bx) {
    const int tid = fresh_tid(), lane = tid & 63, wave = __builtin_amdgcn_readfirstlane(tid >> 6), gw = bx * NWAVES + wave, NGW = G * NWAVES;
    for (int m = gw; m < M; m += NGW) {
        const f32x4* xr = (const f32x4*)(X + (size_t)m * DM) + lane;
        unsigned long long* o8 = (unsigned long long*)(ob + (size_t)m * DM) + lane;
#pragma unroll
        for (int j = 0; j < 4; ++j) { const f32x4 o = xr[64 * j]; o8[64 * j] = (unsigned long long)pk2(o.x, o.y) | ((unsigned long long)pk2(o.z, o.w) << 32); }
    }
}

__device__ __forceinline__ void mix_sgu(const Args& a, int l, int ck, int h, LAS unsigned char* lds) {
    const int tid = fresh_tid(), lane = tid & 63, wave = __builtin_amdgcn_readfirstlane(tid >> 6);
    const bf16* P = (const bf16*)(a.ws + WS_R1); bf16* MX = (bf16*)(a.ws + WS_MIX);
    LAS float* vt = (LAS float*)lds;
    const int row0 = ck * CHUNK;
    {
        const int s = tid >> 2, q = tid & 3;
        const v4u* src = (const v4u*)(P + (size_t)(row0 + s) * PW + PC_V + 64 * h + 16 * q);
        const v4u w0 = src[0], w1 = src[1]; float f[16]; UNPACK8(w0, f, 0); UNPACK8(w1, f, 8);
        float sm = 0.f;
#pragma unroll
        for (int j = 0; j < 16; ++j) sm += f[j];
        sm += __shfl_xor(sm, 1); sm += __shfl_xor(sm, 2);
        const float mean = sm * (1.f / 64.f); float s2 = 0.f;
#pragma unroll
        for (int j = 0; j < 16; ++j) { f[j] -= mean; s2 += f[j] * f[j]; }
        s2 += __shfl_xor(s2, 1); s2 += __shfl_xor(s2, 2);
        const float rstd = 1.f / sqrtf(s2 * (1.f / 64.f) + LN_EPS);
        const f32x4* gp = (const f32x4*)(a.sgu_ln_g + (size_t)l * SW + 64 * h + 16 * q);
#pragma unroll
        for (int j4 = 0; j4 < 4; ++j4) { const f32x4 gv = gp[j4]; f32x4 o; o.x = f[4 * j4] * rstd * gv.x; o.y = f[4 * j4 + 1] * rstd * gv.y; o.z = f[4 * j4 + 2] * rstd * gv.z; o.w = f[4 * j4 + 3] * rstd * gv.w;
            *(LAS f32x4*)(vt + s * 64 + 16 * q + 4 * j4) = o; }
    }
    __syncthreads();
    float acc[16];
#pragma unroll
    for (int i = 0; i < 16; ++i) acc[i] = 0.f;
    cfloat* Wc = (cfloat*)(a.w_spatial + (size_t)(l * 6 + h) * CHUNK * CHUNK);
#pragma unroll 1
    for (int sb = 0; sb < 8; ++sb) {
        float vr[16];
#pragma unroll
        for (int j = 0; j < 16; ++j) vr[j] = vt[(16 * sb + j) * 64 + lane];
#pragma unroll
        for (int i = 0; i < 16; ++i) {
            if (i >= 2 * sb) {
                const int t = wave + 8 * i;
                cfloat* wrow = Wc + t * CHUNK + 16 * sb;
#pragma unroll
                for (int j = 0; j < 16; ++j) { float wv = wrow[j]; wv = (16 * sb + j <= t) ? wv : 0.f; acc[i] += wv * vr[j]; }
            }
        }
    }
    const float* bs = a.b_spatial + (size_t)(l * 6 + h) * CHUNK;
#pragma unroll
    for (int i = 0; i < 16; ++i) { const int t = wave + 8 * i;
        const float u = bflo((unsigned)P[(size_t)(row0 + t) * PW + PC_U + 64 * h + lane]);
        MX[(size_t)(row0 + t) * DM + 640 + 64 * h + lane] = (bf16)f2bf(u * (acc[i] + bs[t])); }
    __syncthreads();
}
__device__ __forceinline__ void mix_pool(const Args& a, int l, int ck, int g, LAS unsigned char* lds) {
    const int tid = fresh_tid(), lane = tid & 63, wave = __builtin_amdgcn_readfirstlane(tid >> 6);
    const bf16* P = (const bf16*)(a.ws + WS_R1); bf16* MX = (bf16*)(a.ws + WS_MIX);
    LAS float* pt = (LAS float*)lds;
    LAS float* dt = pt + 144 * 64;
    LAS float* wp = (LAS float*)(lds + 73728);
    const int row0 = ck * CHUNK; const bool first = (ck % (SEQ / CHUNK)) == 0; const int win = 2 << g;
    {   const int r = tid >> 2, q = tid & 3;
        const v4u* src = (const v4u*)(P + (size_t)(row0 + r) * PW + PC_P + 64 * g + 16 * q);
        const v4u w0 = src[0], w1 = src[1]; float f[16]; UNPACK8(w0, f, 0); UNPACK8(w1, f, 8);
#pragma unroll
        for (int j = 0; j < 16; ++j) pt[(16 + r) * 64 + 16 * q + j] = f[j];
        if (tid < 64) {
            float hf[16];
            if (first) {
#pragma unroll
                for (int j = 0; j < 16; ++j) hf[j] = 0.f;
            } else { const v4u* hs = (const v4u*)(P + (size_t)(row0 - 16 + r) * PW + PC_P + 64 * g + 16 * q); const v4u h0 = hs[0], h1 = hs[1]; UNPACK8(h0, hf, 0); UNPACK8(h1, hf, 8); }
#pragma unroll
            for (int j = 0; j < 16; ++j) pt[r * 64 + 16 * q + j] = hf[j];
        }
        const f32x4* ws = (const f32x4*)(a.w_pool + (size_t)(l * 4 + g) * 64 * 64) + tid * 2;
        const f32x4 x0 = ws[0], x1 = ws[1]; *(LAS f32x4*)(wp + tid * 8) = x0; *(LAS f32x4*)(wp + tid * 8 + 4) = x1;
    }
    __syncthreads();
    {   const int tb = (ck % (SEQ / CHUNK)) * CHUNK;
#pragma unroll 4
        for (int i = 0; i < 16; ++i) { const int t = wave + 8 * i; float s = 0.f;
            for (int j = 0; j < win; ++j) s += pt[(16 + t - j) * 64 + lane];
            const int cnt = (tb + t + 1) < win ? (tb + t + 1) : win;
            dt[t * 65 + lane] = s / (float)cnt - pt[(16 + t) * 64 + lane]; }
    }
    __syncthreads();
    {   const int t = tid >> 2, q = tid & 3; float acc[16];
#pragma unroll
        for (int j = 0; j < 16; ++j) acc[j] = 0.f;
#pragma unroll 4
        for (int c = 0; c < 64; ++c) { const float dv = dt[t * 65 + c];
#pragma unroll
            for (int j4 = 0; j4 < 4; ++j4) { const f32x4 wv = *(const LAS f32x4*)(wp + c * 64 + 16 * q + 4 * j4);
                acc[4 * j4] += dv * wv.x; acc[4 * j4 + 1] += dv * wv.y; acc[4 * j4 + 2] += dv * wv.z; acc[4 * j4 + 3] += dv * wv.w; } }
        const float* ps = a.pool_scale + (size_t)l * PWID + 64 * g + 16 * q;
        v4u o0, o1;
        o0.x = pk2(acc[0] * ps[0], acc[1] * ps[1]); o0.y = pk2(acc[2] * ps[2], acc[3] * ps[3]); o0.z = pk2(acc[4] * ps[4], acc[5] * ps[5]); o0.w = pk2(acc[6] * ps[6], acc[7] * ps[7]);
        o1.x = pk2(acc[8] * ps[8], acc[9] * ps[9]); o1.y = pk2(acc[10] * ps[10], acc[11] * ps[11]); o1.z = pk2(acc[12] * ps[12], acc[13] * ps[13]); o1.w = pk2(acc[14] * ps[14], acc[15] * ps[15]);
        v4u* dst = (v4u*)(MX + (size_t)(row0 + t) * DM + 384 + 64 * g + 16 * q); dst[0] = o0; dst[1] = o1;
    }
    __syncthreads();
}
__device__ __forceinline__ void mix_conv(const Args& a, int l, int ck, int hc, LAS unsigned char* lds) {
    const int tid = fresh_tid(), lane = tid & 63, wave = __builtin_amdgcn_readfirstlane(tid >> 6);
    const bf16* P = (const bf16*)(a.ws + WS_R1); bf16* MX = (bf16*)(a.ws + WS_MIX);
    LAS float* zt = (LAS float*)lds;
    const int row0 = ck * CHUNK; const bool first = (ck % (SEQ / CHUNK)) == 0;
    const int t = tid >> 2, q = tid & 3, cb = 64 * hc + 16 * q;
    float z[16];
    {   const v4u* sx = (const v4u*)(P + (size_t)(row0 + t) * PW + PC_XA + cb); const v4u* sg = (const v4u*)(P + (size_t)(row0 + t) * PW + PC_GC + cb);
        const v4u x0 = sx[0], x1 = sx[1], g0 = sg[0], g1 = sg[1]; float fx[16], fg[16]; UNPACK8(x0, fx, 0); UNPACK8(x1, fx, 8); UNPACK8(g0, fg, 0); UNPACK8(g1, fg, 8);
#pragma unroll
        for (int j = 0; j < 16; ++j) { z[j] = fx[j] * fg[j]; zt[(2 + t) * 64 + 16 * q + j] = z[j]; }
        if (tid < 8) {
            float hz[16];
            if (first) {
#pragma unroll
                for (int j = 0; j < 16; ++j) hz[j] = 0.f;
            } else { const v4u* hx = (const v4u*)(P + (size_t)(row0 - 2 + t) * PW + PC_XA + cb); const v4u* hg = (const v4u*)(P + (size_t)(row0 - 2 + t) * PW + PC_GC + cb);
                const v4u a0 = hx[0], a1 = hx[1], b0 = hg[0], b1 = hg[1]; float hx_[16], hg_[16]; UNPACK8(a0, hx_, 0); UNPACK8(a1, hx_, 8); UNPACK8(b0, hg_, 0); UNPACK8(b1, hg_, 8);
#pragma unroll
                for (int j = 0; j < 16; ++j) hz[j] = hx_[j] * hg_[j]; }
#pragma unroll
            for (int j = 0; j < 16; ++j) zt[t * 64 + 16 * q + j] = hz[j];
        }
    }
    __syncthreads();
    {   const float* wc = a.w_conv + (size_t)l * 3 * CW + cb;
        const v4u* sb = (const v4u*)(P + (size_t)(row0 + t) * PW + PC_GB + cb); const v4u b0 = sb[0], b1 = sb[1]; float fb[16]; UNPACK8(b0, fb, 0); UNPACK8(b1, fb, 8);
        float y[16];
#pragma unroll
        for (int j = 0; j < 16; ++j) y[j] = fb[j] * (wc[j] * zt[t * 64 + 16 * q + j] + wc[CW + j] * zt[(t + 1) * 64 + 16 * q + j] + wc[2 * CW + j] * z[j]);
        v4u o0, o1;
        o0.x = pk2(y[0], y[1]); o0.y = pk2(y[2], y[3]); o0.z = pk2(y[4], y[5]); o0.w = pk2(y[6], y[7]);
        o1.x = pk2(y[8], y[9]); o1.y = pk2(y[10], y[11]); o1.z = pk2(y[12], y[13]); o1.w = pk2(y[14], y[15]);
        v4u* dst = (v4u*)(MX + (size_t)(row0 + t) * DM + cb); dst[0] = o0; dst[1] = o1;
    }
    __syncthreads();
}

#define XB_TMO      128
#define XB_XCNT(j)  (256  + 64 * (j))
#define XB_XSUB(j)  (1280 + 64 * (j))
#define XB_XGEN(j)  (2304 + 64 * (j))
#define XB_TOP      3328
#define XB_TOPGEN   3392
#define XCD_BAR_WORDS 3456
#define XB_SPIN_CAP (1u << 18)

__device__ __forceinline__ unsigned xb_ld(unsigned* p)              { return __hip_atomic_load(p, __ATOMIC_RELAXED, __HIP_MEMORY_SCOPE_AGENT); }
__device__ __forceinline__ unsigned xb_add(unsigned* p, unsigned v) { return __hip_atomic_fetch_add(p, v, __ATOMIC_RELAXED, __HIP_MEMORY_SCOPE_AGENT); }
__device__ __forceinline__ unsigned xb_xcc_id() { return (unsigned)__builtin_amdgcn_s_getreg((3 << 11) | 20) & 0xFu; }
#define XB_SPIN(cond, bar) do { unsigned _sp = 0; while (cond) { __builtin_amdgcn_s_sleep(1); \
    if ((++_sp & 255u) == 0u) { if (xb_ld(&(bar)[XB_TMO])) break; if (_sp > XB_SPIN_CAP) { atomicAdd(&(bar)[XB_TMO], 1u); break; } } } } while (0)

struct XcdBarrier {
    unsigned* bar; unsigned x;
    volatile LAS unsigned* st;
};

__device__ __forceinline__ XcdBarrier xcd_barrier_post(unsigned* bar, volatile LAS unsigned* st) {
    XcdBarrier b; b.bar = bar; b.x = xb_xcc_id(); b.st = st;
    if (threadIdx.x == 0) (void)xb_add(&bar[XB_XCNT(b.x)], 1u);
    return b;
}
__device__ __forceinline__ void xcd_barrier_complete(unsigned* bar, unsigned x, unsigned& nloc, unsigned& nx) {
    const unsigned G = gridDim.x * gridDim.y * gridDim.z;
    unsigned sum, cnt, mine, sp = 0u;
    for (;;) {
        sum = 0u; cnt = 0u; mine = 0u;
#pragma unroll
        for (unsigned j = 0; j < 16; ++j) { const unsigned c = xb_ld(&bar[XB_XCNT(j)]); sum += c; cnt += (c > 0u) ? 1u : 0u; mine = (j == x) ? c : mine; }
        if (sum == G) break;
        __builtin_amdgcn_s_sleep(1);
        if ((++sp & 255u) == 0u) { if (xb_ld(&bar[XB_TMO])) break; if (sp > XB_SPIN_CAP) { atomicAdd(&bar[XB_TMO], 1u); break; } }
    }
    nloc = mine > 0u ? mine : 1u; nx = cnt > 0u ? cnt : 1u;
}

__device__ __forceinline__ void xcd_barrier(const XcdBarrier& b) {
    asm volatile("s_waitcnt vmcnt(0)" ::: "memory");
    __syncthreads();
    if (threadIdx.x == 0) {
        unsigned* bar = b.bar;
        __builtin_amdgcn_s_waitcnt(0);
        unsigned nloc = b.st[0], nx = b.st[1];
        if (nloc == 0u) { xcd_barrier_complete(bar, b.x, nloc, nx); b.st[0] = nloc; b.st[1] = nx; }
        const unsigned old = xb_add(&bar[XB_XSUB(b.x)], 1u);
        const unsigned gen = old / nloc;
        if (old + 1u == (gen + 1u) * nloc) {
            __builtin_amdgcn_fence(__ATOMIC_RELEASE, "agent");
            asm volatile("s_waitcnt vmcnt(0)" ::: "memory");
            const unsigned og = xb_add(&bar[XB_TOP], 1u);
            const unsigned tg = og / nx;
            if (og + 1u == (tg + 1u) * nx) xb_add(&bar[XB_TOPGEN], 1u);
            else XB_SPIN(xb_ld(&bar[XB_TOPGEN]) == tg, bar);
            __builtin_amdgcn_fence(__ATOMIC_ACQUIRE, "agent");
            xb_add(&bar[XB_XGEN(b.x)], 1u);
            asm volatile("s_waitcnt vmcnt(0)" ::: "memory");
        } else {
            XB_SPIN(xb_ld(&bar[XB_XGEN(b.x)]) == gen, bar);
            __builtin_amdgcn_fence(__ATOMIC_ACQUIRE, "agent");
            asm volatile("s_waitcnt vmcnt(0)" ::: "memory");
        }
    }
    __syncthreads();
}

__global__ void __launch_bounds__(NTHR, 2) fwd_mega(Args a) {
    extern __shared__ __attribute__((aligned(16))) unsigned char lds_raw[];
    cg::grid_group grid = cg::this_grid();
    LAS unsigned char* lds = (LAS unsigned char*)lds_raw;
    const int G = gridDim.x, bx = blockIdx.x;
    volatile LAS unsigned* MISC = (volatile LAS unsigned*)(lds + 131072);
    if (threadIdx.x < 64) MISC[threadIdx.x] = 0u;
    __syncthreads();
    const XcdBarrier bar = xcd_barrier_post((unsigned*)(a.ws) + 4096, MISC + 8);
#define GRID_BAR() xcd_barrier(bar)
    bf16* Wb = (bf16*)(a.ws + WS_W); bf16* AB = (bf16*)(a.ws + WS_AB); bf16* MX = (bf16*)(a.ws + WS_MIX);
    float* Y = (float*)(a.ws + WS_Y); bf16* PR = (bf16*)(a.ws + WS_R1); bf16* HH = (bf16*)(a.ws + WS_R1);

    convert_layer(a, 0, lds, G, bx);
    cvt_rows(a.x, AB, G, bx);
    grid.sync();

    for (int l = 0; l < DEPTH; ++l) {
        {   pg8::Gemm g{AB, Wb + WOFF_IN, M, PW, DM}; pg8::StaticOrder S; S.init(M, PW, G, bx);
            EpiProj E{PR, PW, 3};
            pg8::gemm_phase<EpiProj, pg8::StaticOrder, true, true>(lds, g, S, E); }
        GRID_BAR();
        for (int it = bx; it < 128 * 16; it += G) {
            const int part = it >> 7, ck = it & 127;
            if (part < 6) mix_sgu(a, l, ck, part, lds);
            else if (part < 10) mix_pool(a, l, ck, part - 6, lds);
            else mix_conv(a, l, ck, part - 10, lds);
        }
        GRID_BAR();
        {   pg8::Gemm g{MX, Wb + WOFF_O, M, DM, DM}; pg8::StaticOrder S; S.init(M, DM, G, bx);
            EpiRes E{l == 0 ? a.x : a.out, Y, DM, ALPHA};
            pg8::gemm_phase<EpiRes, pg8::StaticOrder, true, true>(lds, g, S, E); }
        GRID_BAR();
        ln_rows(Y, a.ln1_g + (size_t)l * DM, a.ln1_b + (size_t)l * DM, Y, AB, G, bx);
        GRID_BAR();
        {   pg8::Gemm g{AB, Wb + WOFF_GU, M, 2 * DFF, DM}; pg8::StaticOrder S; S.init(M, 2 * DFF, G, bx);
            EpiSwiglu E{HH, DFF};
            pg8::gemm_phase<EpiSwiglu, pg8::StaticOrder, true, true>(lds, g, S, E); }
        GRID_BAR();
        {   pg8::Gemm g{HH, Wb + WOFF_DN, M, DM, DFF}; pg8::StaticOrder S; S.init(M, DM, G, bx);
            EpiRes E{Y, Y, DM, ALPHA};
            pg8::gemm_phase<EpiRes, pg8::StaticOrder, true, true>(lds, g, S, E); }
        GRID_BAR();
        ln_rows(Y, a.ln2_g + (size_t)l * DM, a.ln2_b + (size_t)l * DM, a.out, AB, G, bx);
        if (l + 1 < DEPTH) { convert_layer(a, l + 1, lds, G, bx); GRID_BAR(); }
    }
}

extern "C" void kernel_launch(void* const* d_in, const int* in_sizes, int n_in, void* d_out, int out_size, void* d_ws, size_t ws_size, hipStream_t stream) {
    static int grid = 0;
    if (grid == 0) {
        if (n_in != 15 || ws_size < WS_END) { fprintf(stderr, "kernel_launch: unexpected n_in %d / ws %zu\n", n_in, ws_size); grid = -1; return; }
        int dev = 0, cus = 0, per_cu = 0;
        (void)hipGetDevice(&dev); (void)hipDeviceGetAttribute(&cus, hipDeviceAttributeMultiprocessorCount, dev);
        (void)hipFuncSetAttribute((const void*)fwd_mega, hipFuncAttributeMaxDynamicSharedMemorySize, LDS_BYTES);
        (void)hipOccupancyMaxActiveBlocksPerMultiprocessor(&per_cu, (const void*)fwd_mega, NTHR, LDS_BYTES);
        if (per_cu < 1) { fprintf(stderr, "kernel_launch: occupancy query says %d blocks per CU\n", per_cu); per_cu = 1; }
        (void)hipGetLastError();
        grid = cus;
    }
    if (grid < 0) return;
    (void)hipMemsetAsync(d_ws, 0, 1u << 20, stream);
    Args a{};
    a.x = (const float*)d_in[0]; a.w_in = (const float*)d_in[1]; a.w_conv = (const float*)d_in[2]; a.w_pool = (const float*)d_in[3]; a.pool_scale = (const float*)d_in[4];
    a.sgu_ln_g = (const float*)d_in[5]; a.w_spatial = (const float*)d_in[6]; a.b_spatial = (const float*)d_in[7]; a.w_o = (const float*)d_in[8];
    a.ln1_g = (const float*)d_in[9]; a.ln1_b = (const float*)d_in[10]; a.w_gate_up = (const float*)d_in[11]; a.w_down = (const float*)d_in[12];
    a.ln2_g = (const float*)d_in[13]; a.ln2_b = (const float*)d_in[14];
    a.out = (float*)d_out; a.ws = (unsigned char*)d_ws;
    void* args[] = {&a};
    hipError_t e = hipLaunchCooperativeKernel((const void*)fwd_mega, dim3(grid), dim3(NTHR), args, LDS_BYTES, stream);
    if (e != hipSuccess) fprintf(stderr, "cooperative launch failed: %s (grid %d)\n", hipGetErrorString(e), grid);
}
```

```cpp
#include <hip/hip_runtime.h>
#include <hip/hip_cooperative_groups.h>
#include <cstdio>
#include <cstdint>
namespace pg8 {
#define PG8_LAS __attribute__((address_space(3)))
typedef unsigned short bf16_t;
typedef short bf16x8 __attribute__((ext_vector_type(8)));
typedef float f32x4 __attribute__((ext_vector_type(4)));
typedef unsigned u32x4 __attribute__((ext_vector_type(4)));
constexpr int BM = 256, BK = 64, HALF = 128, HTB = HALF * BK * 2  , STAGE_BYTES = 8 * HTB, NXCD = 8, WGM = 8;

__host__ __device__ __forceinline__ int lds_byte(int r, int c) { const int st = (r >> 4) * 2 + (c >> 5), rr = r & 15, cc = c & 31, ob = rr * 64 + cc * 2; return st * 1024 + (ob ^ (((ob >> 9) & 1) << 5)); }
__host__ __device__ __forceinline__ void stage_rc(int b, int& R, int& C) { const int st = b / 1024, sb = b % 1024, swz = sb ^ (((sb >> 9) & 1) << 5); R = (st >> 1) * 16 + swz / 64; C = (st & 1) * 32 + (swz % 64) / 2; }
__host__ __device__ __forceinline__ int perm32(int rho) { const int n = rho >> 4, i = rho & 15; return 8 * (i >> 2) + 4 * n + (i & 3); }

struct Unit { int pm, pn; };
struct Gemm { const bf16_t* A; const bf16_t* Bt; int M, N, K; };

struct StaticOrder {
    int nM, nN, nwg, G, c;
    __host__ __device__ void init(int M, int N, int G_, int c_) { nM = M / BM; nN = N / BM; nwg = nM * nN; G = G_; c = c_; }
    __host__ __device__ bool next(int i, Unit& u) const {
        const long L = (long)i * G + c; if (L >= nwg) return false;
        int wgid = (int)L; { const int q = nwg / NXCD, r = nwg % NXCD, xcd = wgid % NXCD, off = wgid / NXCD; wgid = (xcd < r ? xcd * (q + 1) : r * (q + 1) + (xcd - r) * q) + off; }
        const int nig = WGM * nN, gid = wgid / nig, fm = gid * WGM, gsz = (nM - fm) < WGM ? (nM - fm) : WGM;
        u.pm = fm + ((wgid % nig) % gsz); u.pn = (wgid % nig) / gsz; return true;
    }
    __device__ __forceinline__ void a_ready(const Unit&) const {}
    __device__ __forceinline__ void done(const Unit&) const {}
};

__device__ __forceinline__ unsigned cvt_pk_bf16(float lo, float hi) { unsigned r; asm volatile("v_cvt_pk_bf16_f32 %0, %1, %2" : "=v"(r) : "v"(lo), "v"(hi)); return r; }
typedef float f32x2 __attribute__((ext_vector_type(2)));
__device__ __forceinline__ f32x2 gelu_pk(f32x2 v) {
    const f32x2 av = __builtin_elementwise_abs(v), d = av * 0.2316418882f + 1.0f;
    f32x2 t; t.x = __builtin_amdgcn_rcpf(d.x); t.y = __builtin_amdgcn_rcpf(d.y);
    f32x2 q = t * 0.5307027145f + (-0.7265760135f); q = q * t + 0.7107068705f; q = q * t + (-0.142248368f); q = q * t + 0.127414796f; q = q * t;
    const f32x2 s = (v * v) * (-0.72134752044f);
    f32x2 e; e.x = __builtin_amdgcn_exp2f(s.x); e.y = __builtin_amdgcn_exp2f(s.y);
    const f32x2 m = v * (q * e), r = v - m;
    f32x2 o; o.x = v.x < 0.f ? m.x : r.x; o.y = v.y < 0.f ? m.y : r.y; return o;
}

template <int ACT  > struct EpiBf16 {
    static constexpr bool PERM = true, AFTER_DRAIN = false; static_assert(ACT == 0 || ACT == 1, "EpiBf16: ACT is 0 (none) or 1 (gelu_pk)");
    bf16_t* O; int ldc; const float* bias; int split_cols; size_t split_stride; float scale0;
    __device__ __forceinline__ void operator()(const f32x4 (&acc)[2][2][4][2], const Unit& u, int wr, int wc, int fr, int fq) const {
        const int row0 = u.pm * BM + wr * 64 + fr; int colt = u.pn * BM; bf16_t* base = O;
        float sc = 1.f; if (split_cols) { const int t = colt / split_cols; base += (size_t)t * split_stride; colt -= t * split_cols; if (t == 0) sc = scale0; }
        const int col0 = colt + wc * 32 + 8 * fq, bcol0 = u.pn * BM + wc * 32 + 8 * fq;
        f32x4 bv[2][2];
#pragma unroll
        for (int bj = 0; bj < 2; ++bj)
#pragma unroll
            for (int n = 0; n < 2; ++n) bv[bj][n] = bias ? *(const f32x4*)(bias + bcol0 + bj * HALF + 4 * n) : (f32x4){0.f, 0.f, 0.f, 0.f};
#pragma unroll
        for (int ai = 0; ai < 2; ++ai)
#pragma unroll
            for (int m = 0; m < 4; ++m) { bf16_t* rowp = base + (size_t)(row0 + ai * HALF + m * 16) * ldc + col0;
#pragma unroll
                for (int bj = 0; bj < 2; ++bj) { f32x4 v0 = acc[ai][bj][m][0] + bv[bj][0], v1 = acc[ai][bj][m][1] + bv[bj][1];
                    if (ACT == 1) { f32x2 a = gelu_pk((f32x2){v0[0], v0[1]}), b = gelu_pk((f32x2){v0[2], v0[3]}), c = gelu_pk((f32x2){v1[0], v1[1]}), d = gelu_pk((f32x2){v1[2], v1[3]});
                        v0 = (f32x4){a.x, a.y, b.x, b.y}; v1 = (f32x4){c.x, c.y, d.x, d.y}; }
                    v0 = v0 * sc; v1 = v1 * sc; u32x4 w; w.x = cvt_pk_bf16(v0[0], v0[1]); w.y = cvt_pk_bf16(v0[2], v0[3]); w.z = cvt_pk_bf16(v1[0], v1[1]); w.w = cvt_pk_bf16(v1[2], v1[3]);
                    *(u32x4*)(rowp + bj * HALF) = w; } }
    }
};

struct PanelStats {
    unsigned* xbuf;
    unsigned* cnt;
    unsigned* tmo;
    int ntn; float eps;
    unsigned code;
    __device__ __forceinline__ bool run(const f32x4 (&v)[2][2][4][2], const Unit& u, int wr, int wc, int fr, int fq, PG8_LAS unsigned char* lds, int wid, int lane) const {
        typedef float f32x2v __attribute__((ext_vector_type(2)));
        PG8_LAS f32x2v* P = (PG8_LAS f32x2v*)lds;
        PG8_LAS f32x2v* S = (PG8_LAS f32x2v*)(lds + 8192);
        PG8_LAS unsigned* flag = (PG8_LAS unsigned*)(lds + 8192 + 2048);
#pragma unroll
        for (int ai = 0; ai < 2; ++ai)
#pragma unroll
            for (int m = 0; m < 4; ++m) {
                float s = 0.f;
#pragma unroll
                for (int bj = 0; bj < 2; ++bj)
#pragma unroll
                    for (int n = 0; n < 2; ++n) { const f32x4 x = v[ai][bj][m][n]; s += (x[0] + x[1]) + (x[2] + x[3]); }
                s += __shfl_xor(s, 16); s += __shfl_xor(s, 32);
                const float mw = s * (1.0f / 64.0f); float q = 0.f;
#pragma unroll
                for (int bj = 0; bj < 2; ++bj)
#pragma unroll
                    for (int n = 0; n < 2; ++n) { const f32x4 d = v[ai][bj][m][n] - mw; q += (d[0] * d[0] + d[1] * d[1]) + (d[2] * d[2] + d[3] * d[3]); }
                q += __shfl_xor(q, 16); q += __shfl_xor(q, 32);
                if (fq == 0) P[(ai * HALF + wr * 64 + m * 16 + fr) * 4 + wc] = (f32x2v){mw, q};
            }
        asm volatile("s_waitcnt lgkmcnt(0)" ::: "memory"); __builtin_amdgcn_s_barrier(); asm volatile("" ::: "memory");
#if defined(BROKEN_EXCHANGE_NO_WAIT)
#warning BROKEN CONTROL BUILD: the row-statistics exchange does not wait; results are wrong by design
        if (blockIdx.x >= 64) { const long long t0_ = clock64(); while (clock64() - t0_ < 60000) __builtin_amdgcn_s_sleep(8); }
#endif
        const int row = wid * 32 + (lane & 31);
        if (lane < 32) {
            const f32x2v a = P[row * 4 + 0], b = P[row * 4 + 1], c = P[row * 4 + 2], d = P[row * 4 + 3];
            const float mt = (a.x + b.x + c.x + d.x) * 0.25f;
            const float da = a.x - mt, db = b.x - mt, dc = c.x - mt, dd = d.x - mt;
            const float m2 = (a.y + b.y) + (c.y + d.y) + 64.0f * ((da * da + db * db) + (dc * dc + dd * dd));
            unsigned long long* slot = (unsigned long long*)xbuf + ((size_t)(u.pm * BM + row) * 4 + u.pn);
            __hip_atomic_store(slot, ((unsigned long long)__float_as_uint(m2) << 32) | __float_as_uint(mt), __ATOMIC_RELAXED, __HIP_MEMORY_SCOPE_AGENT);
        }
        asm volatile("s_waitcnt vmcnt(0)" ::: "memory");
        if (lane == 0) __hip_atomic_fetch_add(cnt + 64 * u.pm, 1u, __ATOMIC_RELAXED, __HIP_MEMORY_SCOPE_AGENT);
        if (wid == 0) {
            bool dead = false; const unsigned long long t0 = __builtin_amdgcn_s_memrealtime(); const unsigned want = 8u * (unsigned)ntn;
            for (;;) {
#if defined(BROKEN_EXCHANGE_NO_WAIT)
                break;
#endif
                if ((unsigned)__builtin_amdgcn_readfirstlane(__hip_atomic_load(cnt + 64 * u.pm, __ATOMIC_RELAXED, __HIP_MEMORY_SCOPE_AGENT)) >= want) break;
                if (__builtin_amdgcn_s_memrealtime() - t0 > 2000000ull) {
                    if (lane == 0) { unsigned expect = 0u; __hip_atomic_compare_exchange_strong(tmo + 1, &expect, code | (unsigned)(u.pm & 0xff), __ATOMIC_RELAXED, __ATOMIC_RELAXED, __HIP_MEMORY_SCOPE_AGENT);
                                     __hip_atomic_store(tmo, 1u, __ATOMIC_RELAXED, __HIP_MEMORY_SCOPE_AGENT); }
                    dead = true; break; }
                __builtin_amdgcn_s_sleep(2);
            }
            __builtin_amdgcn_fence(__ATOMIC_ACQUIRE, "agent");
            if (lane == 0) flag[0] = dead ? 1u : 0u;
        }
        asm volatile("s_waitcnt vmcnt(0) lgkmcnt(0)" ::: "memory"); __builtin_amdgcn_s_barrier(); asm volatile("" ::: "memory");
        const bool bad = flag[0] != 0u;
        if (lane < 32) {
            const unsigned long long* slot = (const unsigned long long*)xbuf + (size_t)(u.pm * BM + row) * 4; float mt[4], m2[4]; float ms = 0.f;
#pragma unroll
            for (int t = 0; t < 4; ++t) { if (t < ntn) { const unsigned long long w = __hip_atomic_load(slot + t, __ATOMIC_RELAXED, __HIP_MEMORY_SCOPE_AGENT); mt[t] = __uint_as_float((unsigned)w); m2[t] = __uint_as_float((unsigned)(w >> 32)); } else { mt[t] = 0.f; m2[t] = 0.f; } ms += mt[t]; }
            const float mean = ms / (float)ntn; float q = 0.f;
#pragma unroll
            for (int t = 0; t < 4; ++t) if (t < ntn) { const float dm = mt[t] - mean; q += m2[t] + 256.0f * dm * dm; }
            S[row] = (f32x2v){mean, 1.0f / sqrtf(q / (256.0f * (float)ntn) + eps)};
        }
        asm volatile("s_waitcnt lgkmcnt(0)" ::: "memory"); __builtin_amdgcn_s_barrier(); asm volatile("" ::: "memory");
        return bad;
    }
};
struct EpiLnRes {
    static constexpr bool PERM = false, AFTER_DRAIN = true;
    const float* base; float* out; int ldc; const float* bias; PanelStats st; unsigned poison;
    __device__ __forceinline__ void fused(f32x4 (&acc)[2][2][4][2], const Unit& u, int wr, int wc, int fr, int fq, PG8_LAS unsigned char* lds, int wid, int lane) const {
        typedef float f32x2v __attribute__((ext_vector_type(2)));
        const PG8_LAS f32x2v* S = (const PG8_LAS f32x2v*)(lds + 8192);
        const int col0 = u.pn * BM + wc * 32 + 4 * fq;
#pragma unroll
        for (int bj = 0; bj < 2; ++bj)
#pragma unroll
            for (int n = 0; n < 2; ++n) { const f32x4 bv = bias ? *(const f32x4*)(bias + col0 + bj * HALF + n * 16) : (f32x4){0.f, 0.f, 0.f, 0.f};
#pragma unroll
                for (int ai = 0; ai < 2; ++ai)
#pragma unroll
                    for (int m = 0; m < 4; ++m) acc[ai][bj][m][n] += bv; }
        f32x4 pre[4][2][2];
#pragma unroll
        for (int m = 0; m < 4; ++m) { const size_t off = (size_t)(u.pm * BM + wr * 64 + m * 16 + fr) * ldc + col0;
#pragma unroll
            for (int bj = 0; bj < 2; ++bj)
#pragma unroll
                for (int n = 0; n < 2; ++n) pre[m][bj][n] = *(const f32x4*)(base + off + bj * HALF + n * 16); }
        const bool bad = st.run(acc, u, wr, wc, fr, fq, lds, wid, lane) || poison != 0u;
        const float qnan = __builtin_nanf("");
#pragma unroll
        for (int ai = 0; ai < 2; ++ai)
#pragma unroll
            for (int m = 0; m < 4; ++m) { const int r = ai * HALF + wr * 64 + m * 16 + fr; const f32x2v sr = S[r]; const size_t off = (size_t)(u.pm * BM + r) * ldc + col0;
#pragma unroll
                for (int bj = 0; bj < 2; ++bj)
#pragma unroll
                    for (int n = 0; n < 2; ++n) { const f32x4 bs = ai == 0 ? pre[m][bj][n] : *(const f32x4*)(base + off + bj * HALF + n * 16); f32x4 o = bs + (acc[ai][bj][m][n] - sr.x) * sr.y;
                        if (bad) o = (f32x4){qnan, qnan, qnan, qnan}; *(f32x4*)(out + off + bj * HALF + n * 16) = o; }
                if (m & 1) asm volatile("" ::: "memory"); }
    }
};
struct EpiLnResLn {
    static constexpr bool PERM = false, AFTER_DRAIN = true;
    const float* base; float* out; bf16_t* xn; int ldc; const float* bias; PanelStats st1, st2; unsigned poison;
    __device__ __forceinline__ void fused(f32x4 (&acc)[2][2][4][2], const Unit& u, int wr, int wc, int fr, int fq, PG8_LAS unsigned char* lds, int wid, int lane) const {
        typedef float f32x2v __attribute__((ext_vector_type(2))); typedef unsigned u32x2v __attribute__((ext_vector_type(2)));
        const PG8_LAS f32x2v* S = (const PG8_LAS f32x2v*)(lds + 8192);
        const int col0 = u.pn * BM + wc * 32 + 4 * fq;
#pragma unroll
        for (int bj = 0; bj < 2; ++bj)
#pragma unroll
            for (int n = 0; n < 2; ++n) { const f32x4 bv = bias ? *(const f32x4*)(bias + col0 + bj * HALF + n * 16) : (f32x4){0.f, 0.f, 0.f, 0.f};
#pragma unroll
                for (int ai = 0; ai < 2; ++ai)
#pragma unroll
                    for (int m = 0; m < 4; ++m) acc[ai][bj][m][n] += bv; }
        bool bad = st1.run(acc, u, wr, wc, fr, fq, lds, wid, lane) || poison != 0u;
        const float qnan = __builtin_nanf("");
#pragma unroll
        for (int ai = 0; ai < 2; ++ai)
#pragma unroll
            for (int m = 0; m < 4; ++m) { const int r = ai * HALF + wr * 64 + m * 16 + fr; const f32x2v sr = S[r]; const size_t off = (size_t)(u.pm * BM + r) * ldc + col0;
#pragma unroll
                for (int bj = 0; bj < 2; ++bj)
#pragma unroll
                    for (int n = 0; n < 2; ++n) { const f32x4 bs = *(const f32x4*)(base + off + bj * HALF + n * 16); acc[ai][bj][m][n] = bs + (acc[ai][bj][m][n] - sr.x) * sr.y; }
                asm volatile("" : "+v"(acc[ai][0][m][0]), "+v"(acc[ai][0][m][1]), "+v"(acc[ai][1][m][0]), "+v"(acc[ai][1][m][1]));
                if (m & 1) asm volatile("" ::: "memory"); }
        const bool bad1 = bad;
        bad = st2.run(acc, u, wr, wc, fr, fq, lds, wid, lane) || bad;
#pragma unroll
        for (int ai = 0; ai < 2; ++ai)
#pragma unroll
            for (int m = 0; m < 4; ++m) { const int r = ai * HALF + wr * 64 + m * 16 + fr; const f32x2v sr = S[r]; const size_t off = (size_t)(u.pm * BM + r) * ldc + col0;
#pragma unroll
                for (int bj = 0; bj < 2; ++bj)
#pragma unroll
                    for (int n = 0; n < 2; ++n) { const f32x4 x1 = acc[ai][bj][m][n]; *(f32x4*)(out + off + bj * HALF + n * 16) = bad1 ? (f32x4){qnan, qnan, qnan, qnan} : x1;
                        const f32x4 o = (x1 - sr.x) * sr.y; u32x2v w; w.x = cvt_pk_bf16(o[0], o[1]); w.y = cvt_pk_bf16(o[2], o[3]);
                        if (bad) { w.x = 0x7fc07fc0u; w.y = 0x7fc07fc0u; } *(u32x2v*)(xn + off + bj * HALF + n * 16) = w; }
                asm volatile("" ::: "memory"); }
    }
};

template <class Epi, class Sched, bool ALIGN_EPI = false, bool SP2 = false>
__device__ __forceinline__ void gemm_phase(PG8_LAS unsigned char* lds, const Gemm g, const Sched& S, const Epi& E) {
    int tid_ = threadIdx.x; asm volatile("" : "+v"(tid_));
    const int tid = tid_, wid = __builtin_amdgcn_readfirstlane(tid >> 6), lane = tid & 63, wr = wid >> 2, wc = wid & 3, fr = lane & 15, fq = lane >> 4;
    const int K = g.K, nt = K / BK;
    unsigned voffA[2], voffB[2];
#pragma unroll
    for (int i = 0; i < 2; ++i) { int R, C; stage_rc(tid * 16 + i * 8192, R, C); const int Rb = Epi::PERM ? ((R & ~31) + perm32(R & 31)) : R;
        voffA[i] = (unsigned)(R * K + C) * 2u; voffB[i] = (unsigned)(Rb * K + C) * 2u; }
    const size_t kstep = (size_t)(BK * 2);
    const size_t hstep = (size_t)HALF * K * 2;
    const size_t tstep = 2 * hstep;
    const unsigned ldsw = (unsigned)wid * 1024u;
    const int aoff = lds_byte(wr * 64 + fr, fq * 8), boff = lds_byte(wc * 32 + fr, fq * 8);
#define PG8_SA(b, h) (((b) * 2 + (h)) * HTB)
#define PG8_SB(b, h) ((4 + (b) * 2 + (h)) * HTB)
#define PG8_STAGE(bufoff, gbase, voff) do { _Pragma("unroll") for (int _i = 0; _i < 2; ++_i) \
        __builtin_amdgcn_global_load_lds((const unsigned*)((const char*)(gbase) + (voff)[_i]), (PG8_LAS unsigned*)(lds + (bufoff) + ldsw + _i * 8192), 16, 0, 0); } while (0)
#define PG8_LDA(dst, b, h) do { _Pragma("unroll") for (int m = 0; m < 4; ++m) _Pragma("unroll") for (int k = 0; k < 2; ++k) dst[m][k] = *(const PG8_LAS bf16x8*)(lds + PG8_SA(b, h) + aoff + m * 2048 + k * 1024); } while (0)
#define PG8_LDB(dst, b, h) do { _Pragma("unroll") for (int n = 0; n < 2; ++n) _Pragma("unroll") for (int k = 0; k < 2; ++k) dst[n][k] = *(const PG8_LAS bf16x8*)(lds + PG8_SB(b, h) + boff + n * 2048 + k * 1024); } while (0)
#define PG8_MMA(ai, bj, At, Bt) do { __builtin_amdgcn_s_setprio(1); _Pragma("unroll") for (int m = 0; m < 4; ++m) _Pragma("unroll") for (int n = 0; n < 2; ++n) _Pragma("unroll") for (int k = 0; k < 2; ++k) \
        acc[ai][bj][m][n] = __builtin_amdgcn_mfma_f32_16x16x32_bf16(Bt[n][k], At[m][k], acc[ai][bj][m][n], 0, 0, 0); __builtin_amdgcn_s_setprio(0); } while (0)
#define PG8_WAIT_V(n) asm volatile("s_waitcnt vmcnt(" #n ")" ::: "memory")
#define PG8_WAIT_L(n) asm volatile("s_waitcnt lgkmcnt(" #n ")" ::: "memory")
#define PG8_BAR __builtin_amdgcn_s_barrier()
#define PG8_SCHED __builtin_amdgcn_sched_barrier(0)
    Unit cur, nxt; int ui = 0;
    if (!S.next(0, cur)) return;
    f32x4 acc[2][2][4][2];
#pragma unroll
    for (int a = 0; a < 2; ++a)
#pragma unroll
        for (int b = 0; b < 2; ++b)
#pragma unroll
            for (int m = 0; m < 4; ++m)
#pragma unroll
                for (int n = 0; n < 2; ++n) acc[a][b][m][n] = (f32x4){0.f, 0.f, 0.f, 0.f};
    bf16x8 At[4][2], B0[2][2], B1[2][2];
    const char* cA = (const char*)g.A + (size_t)cur.pm * tstep; const char* cB = (const char*)g.Bt + (size_t)cur.pn * tstep;
    S.a_ready(cur);
    if constexpr (SP2) {
        PG8_STAGE(PG8_SB(0, 0), cB, voffB); PG8_STAGE(PG8_SB(0, 1), cB + hstep, voffB); PG8_STAGE(PG8_SA(0, 0), cA, voffA); PG8_STAGE(PG8_SA(0, 1), cA + hstep, voffA);
        if (wr == 1) PG8_BAR;
        PG8_WAIT_V(2); PG8_BAR;
        PG8_STAGE(PG8_SB(1, 0), cB + kstep, voffB); PG8_STAGE(PG8_SA(1, 0), cA + kstep, voffA); PG8_STAGE(PG8_SB(1, 1), cB + hstep + kstep, voffB);
        PG8_WAIT_V(6); PG8_BAR;
    } else {
        PG8_STAGE(PG8_SB(0, 0), cB, voffB); PG8_STAGE(PG8_SA(0, 0), cA, voffA); PG8_STAGE(PG8_SB(0, 1), cB + hstep, voffB); PG8_STAGE(PG8_SA(0, 1), cA + hstep, voffA);
        if (wr == 1) PG8_BAR;
        PG8_WAIT_V(4); PG8_BAR;
        PG8_STAGE(PG8_SB(1, 0), cB + kstep, voffB); PG8_STAGE(PG8_SA(1, 0), cA + kstep, voffA); PG8_STAGE(PG8_SB(1, 1), cB + hstep + kstep, voffB);
        PG8_WAIT_V(6); PG8_BAR;
    }
    for (;;) {
        const bool has_next = S.next(ui + 1, nxt);
        const char* nA = has_next ? (const char*)g.A + (size_t)nxt.pm * tstep : cA; const char* nB = has_next ? (const char*)g.Bt + (size_t)nxt.pn * tstep : cB;
        for (int t = 0; t < nt; t += 2) {
            const bool last = (t == nt - 2);
            const char* a1 = cA + (size_t)(t + 1) * kstep;
            const char* a2 = last ? nA : cA + (size_t)(t + 2) * kstep; const char* b2 = last ? nB : cB + (size_t)(t + 2) * kstep;
            const char* a3 = a2 + kstep; const char* b3 = b2 + kstep;
            if (last && has_next) S.a_ready(nxt);
            if constexpr (SP2) {
            PG8_LDB(B0, 0, 0); PG8_LDB(B1, 0, 1); PG8_SCHED; PG8_LDA(At, 0, 0); PG8_STAGE(PG8_SA(1, 1), a1 + hstep, voffA);
            PG8_WAIT_V(8); PG8_WAIT_L(0); PG8_BAR; PG8_MMA(0, 0, At, B0); PG8_MMA(0, 1, At, B1); PG8_BAR; PG8_SCHED;
            PG8_LDA(At, 0, 1); PG8_STAGE(PG8_SB(0, 0), b2, voffB); PG8_STAGE(PG8_SB(0, 1), b2 + hstep, voffB); PG8_STAGE(PG8_SA(0, 0), a2, voffA);
            PG8_WAIT_V(8); PG8_WAIT_L(0); PG8_BAR; PG8_MMA(1, 0, At, B0); PG8_MMA(1, 1, At, B1); PG8_BAR; PG8_SCHED;
            PG8_LDB(B0, 1, 0); PG8_LDB(B1, 1, 1); PG8_SCHED; PG8_LDA(At, 1, 0); PG8_STAGE(PG8_SA(0, 1), a2 + hstep, voffA);
            PG8_WAIT_V(8); PG8_WAIT_L(0); PG8_BAR; PG8_MMA(0, 0, At, B0); PG8_MMA(0, 1, At, B1); PG8_BAR; PG8_SCHED;
            PG8_LDA(At, 1, 1); PG8_STAGE(PG8_SB(1, 0), b3, voffB); PG8_STAGE(PG8_SB(1, 1), b3 + hstep, voffB); PG8_STAGE(PG8_SA(1, 0), a3, voffA);
            PG8_WAIT_V(8); PG8_WAIT_L(0); PG8_BAR; PG8_MMA(1, 0, At, B0); PG8_MMA(1, 1, At, B1); PG8_BAR; PG8_SCHED;
            } else {
            PG8_LDB(B0, 0, 0); PG8_SCHED; PG8_LDA(At, 0, 0); PG8_STAGE(PG8_SA(1, 1), a1 + hstep, voffA);
            PG8_WAIT_L(8); PG8_BAR; PG8_WAIT_L(0); PG8_MMA(0, 0, At, B0); PG8_BAR; PG8_SCHED;
            PG8_LDB(B1, 0, 1); PG8_STAGE(PG8_SB(0, 0), b2, voffB);
            PG8_BAR; PG8_WAIT_L(0); PG8_MMA(0, 1, At, B1); PG8_BAR;
            PG8_LDA(At, 0, 1); PG8_STAGE(PG8_SA(0, 0), a2, voffA);
            PG8_BAR; PG8_WAIT_L(0); PG8_MMA(1, 0, At, B0); PG8_BAR; PG8_SCHED;
            PG8_STAGE(PG8_SB(0, 1), b2 + hstep, voffB);
            PG8_WAIT_V(6); PG8_BAR; PG8_MMA(1, 1, At, B1); PG8_BAR;
            PG8_LDB(B0, 1, 0); PG8_SCHED; PG8_LDA(At, 1, 0); PG8_STAGE(PG8_SA(0, 1), a2 + hstep, voffA);
            PG8_WAIT_L(8); PG8_BAR; PG8_WAIT_L(0); PG8_MMA(0, 0, At, B0); PG8_BAR; PG8_SCHED;
            PG8_LDB(B1, 1, 1); PG8_STAGE(PG8_SB(1, 0), b3, voffB);
            PG8_BAR; PG8_WAIT_L(0); PG8_MMA(0, 1, At, B1); PG8_BAR;
            PG8_LDA(At, 1, 1); PG8_STAGE(PG8_SA(1, 0), a3, voffA);
            PG8_BAR; PG8_WAIT_L(0); PG8_MMA(1, 0, At, B0); PG8_BAR; PG8_SCHED;
            PG8_STAGE(PG8_SB(1, 1), b3 + hstep, voffB);
            PG8_WAIT_V(6); PG8_BAR; PG8_MMA(1, 1, At, B1); PG8_BAR;
            }
        }
        if constexpr (ALIGN_EPI) { if (wr == 0) PG8_BAR; }
        if constexpr (!Epi::AFTER_DRAIN) { E(acc, cur, wr, wc, fr, fq); S.done(cur); }
        if (!has_next) break;
#pragma unroll
        for (int a = 0; a < 2; ++a)
#pragma unroll
            for (int b = 0; b < 2; ++b)
#pragma unroll
                for (int m = 0; m < 4; ++m)
#pragma unroll
                    for (int n = 0; n < 2; ++n) acc[a][b][m][n] = (f32x4){0.f, 0.f, 0.f, 0.f};
        cur = nxt; cA = nA; cB = nB; ++ui;
        if constexpr (ALIGN_EPI) { if (wr == 1) PG8_BAR; }
    }
    PG8_WAIT_V(0);
    if constexpr (!ALIGN_EPI) { if (wr == 0) PG8_BAR; }
    PG8_BAR;
    if constexpr (Epi::AFTER_DRAIN) { E.fused(acc, cur, wr, wc, fr, fq, lds, wid, lane); S.done(cur); }
#undef PG8_SA
#undef PG8_SB
#undef PG8_STAGE
#undef PG8_LDA
#undef PG8_LDB
#undef PG8_MMA
#undef PG8_WAIT_V
#undef PG8_WAIT_L
#undef PG8_BAR
#undef PG8_SCHED
}
}

namespace cg = cooperative_groups;
#define LAS __attribute__((address_space(3)))
typedef unsigned short bf16;
typedef unsigned v4u __attribute__((ext_vector_type(4)));
typedef float f32x4 __attribute__((ext_vector_type(4)));
typedef const __attribute__((address_space(4))) float cfloat;

constexpr int NWAVES = 8, NTHR = 512;
constexpr int DM = 1024, BATCH = 8, SEQ = 2048, DEPTH = 4, M = BATCH * SEQ;
constexpr int CW = 384, PWID = 256, SW = 384, INW = 2176, PW = 2304  , DFF = 2816, CHUNK = 128;
constexpr float LN_EPS = 1e-5f;
constexpr float ALPHA = 1.681792830507429f;
constexpr int PC_U = 0, PC_V = 384, PC_XA = 768, PC_GB = 1152, PC_GC = 1536, PC_P = 1920;
constexpr size_t MiB = 1u << 20;
constexpr size_t WS_W = 1 * MiB, WS_AB = 24 * MiB, WS_MIX = 56 * MiB, WS_Y = 88 * MiB, WS_R1 = 152 * MiB, WS_END = 240 * MiB;
constexpr size_t WOFF_IN = 0, WOFF_O = (size_t)PW * DM, WOFF_GU = WOFF_O + (size_t)DM * DM, WOFF_DN = WOFF_GU + (size_t)2 * DFF * DM;
static_assert((WOFF_DN + (size_t)DM * DFF) * 2 + WS_W <= WS_AB, "weights fit");
constexpr size_t WS_SP = 65536;
constexpr size_t WS_PT = WS_SP + 6 * 128 * 128 * 2;
static_assert(WS_PT + 4 * 64 * 64 * 2 <= WS_W, "small weights fit");
constexpr int LDS_BYTES = 147456;

__device__ __forceinline__ unsigned f2bf(float f) { unsigned u = __builtin_bit_cast(unsigned, f); return (u + 0x7fffu + ((u >> 16) & 1u)) >> 16; }
__device__ __forceinline__ unsigned pk2(float lo, float hi) { return f2bf(lo) | (f2bf(hi) << 16); }
__device__ __forceinline__ float bflo(unsigned w) { return __builtin_bit_cast(float, w << 16); }
__device__ __forceinline__ float bfhi(unsigned w) { return __builtin_bit_cast(float, w & 0xffff0000u); }
__device__ __forceinline__ float wave_sum(float v) {
#pragma unroll
    for (int o = 1; o < 64; o <<= 1) v += __shfl_xor(v, o);
    return v;
}
#define UNPACK8(V_, f, o) do { f[o+0] = bflo((V_).x); f[o+1] = bfhi((V_).x); f[o+2] = bflo((V_).y); f[o+3] = bfhi((V_).y); f[o+4] = bflo((V_).z); f[o+5] = bfhi((V_).z); f[o+6] = bflo((V_).w); f[o+7] = bfhi((V_).w); } while (0)

__device__ __forceinline__ int fresh_tid() { int t = threadIdx.x; asm volatile("" : "+v"(t)); return t; }
struct Args {
    const float *x, *w_in, *w_conv, *w_pool, *pool_scale, *sgu_ln_g, *w_spatial, *b_spatial, *w_o, *ln1_g, *ln1_b, *w_gate_up, *w_down, *ln2_g, *ln2_b;
    float* out; unsigned char* ws;
};

struct EpiProj {
    static constexpr bool PERM = true, AFTER_DRAIN = false;
    bf16* O; int ldc; int gelu_tiles;
    __device__ __forceinline__ void operator()(const pg8::f32x4 (&acc)[2][2][4][2], const pg8::Unit& u, int wr, int wc, int fr, int fq) const {
        using namespace pg8;
        const int row0 = u.pm * BM + wr * 64 + fr, col0 = u.pn * BM + wc * 32 + 8 * fq;
        const bool act = u.pn < gelu_tiles;
#pragma unroll
        for (int ai = 0; ai < 2; ++ai)
#pragma unroll
            for (int m = 0; m < 4; ++m) { bf16* rowp = O + (size_t)(row0 + ai * HALF + m * 16) * ldc + col0;
#pragma unroll
                for (int bj = 0; bj < 2; ++bj) { pg8::f32x4 v0 = acc[ai][bj][m][0], v1 = acc[ai][bj][m][1];
                    if (act) { f32x2 a = gelu_pk((f32x2){v0[0], v0[1]}), b = gelu_pk((f32x2){v0[2], v0[3]}), c = gelu_pk((f32x2){v1[0], v1[1]}), d = gelu_pk((f32x2){v1[2], v1[3]});
                        v0 = (pg8::f32x4){a.x, a.y, b.x, b.y}; v1 = (pg8::f32x4){c.x, c.y, d.x, d.y}; }
                    u32x4 w; w.x = cvt_pk_bf16(v0[0], v0[1]); w.y = cvt_pk_bf16(v0[2], v0[3]); w.z = cvt_pk_bf16(v1[0], v1[1]); w.w = cvt_pk_bf16(v1[2], v1[3]);
                    *(u32x4*)(rowp + bj * HALF) = w; } }
    }
};
struct EpiRes {
    static constexpr bool PERM = false, AFTER_DRAIN = false;
    const float* X; float* Y; int ldc; float alpha;
    __device__ __forceinline__ void operator()(const pg8::f32x4 (&acc)[2][2][4][2], const pg8::Unit& u, int wr, int wc, int fr, int fq) const {
        using namespace pg8;
        const int row0 = u.pm * BM + wr * 64 + fr, col0 = u.pn * BM + wc * 32 + 4 * fq;
#pragma unroll
        for (int ai = 0; ai < 2; ++ai)
#pragma unroll
            for (int m = 0; m < 4; ++m) { const size_t off = (size_t)(row0 + ai * HALF + m * 16) * ldc + col0;
#pragma unroll
                for (int bj = 0; bj < 2; ++bj)
#pragma unroll
                    for (int n = 0; n < 2; ++n) { const pg8::f32x4 xv = *(const pg8::f32x4*)(X + off + bj * HALF + n * 16);
                        *(pg8::f32x4*)(Y + off + bj * HALF + n * 16) = xv * alpha + acc[ai][bj][m][n]; }
                asm volatile("" ::: "memory"); }
    }
};
struct EpiSwiglu {
    static constexpr bool PERM = true, AFTER_DRAIN = false;
    bf16* H; int ldc;
    __device__ __forceinline__ void operator()(const pg8::f32x4 (&acc)[2][2][4][2], const pg8::Unit& u, int wr, int wc, int fr, int fq) const {
        using namespace pg8;
        const int row0 = u.pm * BM + wr * 64 + fr, col0 = u.pn * HALF + wc * 32 + 8 * fq;
#pragma unroll
        for (int ai = 0; ai < 2; ++ai)
#pragma unroll
            for (int m = 0; m < 4; ++m) { bf16* rowp = H + (size_t)(row0 + ai * HALF + m * 16) * ldc + col0;
                float h[8];
#pragma unroll
                for (int n = 0; n < 2; ++n)
#pragma unroll
                    for (int j = 0; j < 4; ++j) { const float g = acc[ai][0][m][n][j], uu = acc[ai][1][m][n][j];
                        const float s = __builtin_amdgcn_rcpf(1.0f + __builtin_amdgcn_exp2f(g * -1.4426950408889634f)); h[n * 4 + j] = g * s * uu; }
                u32x4 w; w.x = cvt_pk_bf16(h[0], h[1]); w.y = cvt_pk_bf16(h[2], h[3]); w.z = cvt_pk_bf16(h[4], h[5]); w.w = cvt_pk_bf16(h[6], h[7]);
                *(u32x4*)rowp = w; }
    }
};

__device__ __forceinline__ void transpose_item(const float* W, int K, int N, bf16* WT, int k0, int n0, int drow0, LAS float* scr, int lane) {
#pragma unroll 8
    for (int i = 0; i < 32; ++i) { const int kk = 2 * i + (lane >> 5); scr[kk * 33 + (lane & 31)] = W[(size_t)(k0 + kk) * N + n0 + (lane & 31)]; }
    asm volatile("s_waitcnt lgkmcnt(0)" ::: "memory");
    const int c = lane & 7;
#pragma unroll
    for (int j = 0; j < 4; ++j) { const int n = (lane >> 3) + 8 * j; const LAS float* s = scr + (8 * c) * 33 + n;
        v4u o; o.x = pk2(s[0 * 33], s[1 * 33]); o.y = pk2(s[2 * 33], s[3 * 33]); o.z = pk2(s[4 * 33], s[5 * 33]); o.w = pk2(s[6 * 33], s[7 * 33]);
        *(v4u*)(WT + (size_t)(drow0 + n) * K + k0 + 8 * c) = o; }
    asm volatile("s_waitcnt lgkmcnt(0)" ::: "memory");
}
__device__ __forceinline__ void convert_layer(const Args& a, int l, LAS unsigned char* lds, int G, int bx) {
    const int tid = fresh_tid(), lane = tid & 63, wave = __builtin_amdgcn_readfirstlane(tid >> 6), gw = bx * NWAVES + wave, NGW = G * NWAVES;
    LAS float* scr = (LAS float*)(lds + wave * 16384);
    bf16* Wb = (bf16*)(a.ws + WS_W);
    constexpr int I_IN = 16 * 68, I_O = 16 * 32, I_GU = 16 * 176, I_DN = 44 * 32, I_PAD = 128, I_SP = 192, I_PT = 32;
    constexpr int NIT = I_IN + I_O + I_GU + I_DN + I_PAD + I_SP + I_PT;
    for (int it = gw; it < NIT; it += NGW) {
        int r = it;
        if (r < I_IN) { const int kb = r / 68, nb = r % 68, n0 = 32 * nb; const int dr = n0 < 1408 ? n0 + 768 : n0 - 1408;
            transpose_item(a.w_in + (size_t)l * DM * INW, DM, INW, Wb + WOFF_IN, 64 * kb, n0, dr, scr, lane); continue; } r -= I_IN;
        if (r < I_O) { const int kb = r / 32, nb = r % 32; transpose_item(a.w_o + (size_t)l * DM * DM, DM, DM, Wb + WOFF_O, 64 * kb, 32 * nb, 32 * nb, scr, lane); continue; } r -= I_O;
        if (r < I_GU) { const int kb = r / 176, nb = r % 176, n0 = 32 * nb; int dr;
            if (n0 < DFF) dr = 256 * (n0 / 128) + (n0 % 128); else { const int n1 = n0 - DFF; dr = 256 * (n1 / 128) + 128 + (n1 % 128); }
            transpose_item(a.w_gate_up + (size_t)l * DM * 2 * DFF, DM, 2 * DFF, Wb + WOFF_GU, 64 * kb, n0, dr, scr, lane); continue; } r -= I_GU;
        if (r < I_DN) { const int kb = r / 32, nb = r % 32; transpose_item(a.w_down + (size_t)l * DFF * DM, DFF, DM, Wb + WOFF_DN, 64 * kb, 32 * nb, 32 * nb, scr, lane); continue; } r -= I_DN;
        if (r < I_PAD) { v4u z = (v4u){0u, 0u, 0u, 0u}; v4u* p = (v4u*)(Wb + WOFF_IN + (size_t)(INW + r) * DM) + lane * 2; p[0] = z; p[1] = z; continue; } r -= I_PAD;
        if (r < I_SP) { const int idx = (r * 64 + lane) * 8, tt = (idx >> 7) & 127, s0 = idx & 127;
            const f32x4* src = (const f32x4*)(a.w_spatial + (size_t)l * 6 * CHUNK * CHUNK + idx); const f32x4 x0 = src[0], x1 = src[1];
            float f[8] = {x0.x, x0.y, x0.z, x0.w, x1.x, x1.y, x1.z, x1.w};
#pragma unroll
            for (int j = 0; j < 8; ++j) f[j] = (s0 + j <= tt) ? f[j] : 0.f;
            v4u o; o.x = pk2(f[0], f[1]); o.y = pk2(f[2], f[3]); o.z = pk2(f[4], f[5]); o.w = pk2(f[6], f[7]);
            *(v4u*)((bf16*)(a.ws + WS_SP) + idx) = o; continue; } r -= I_SP;
        { const int i8 = r * 64 + lane, gg = i8 >> 9, dd = (i8 >> 3) & 63, c0 = (i8 & 7) * 8;
            const float* src = a.w_pool + ((size_t)(l * 4 + gg) * 64 + c0) * 64 + dd;
            v4u o; o.x = pk2(src[0], src[64]); o.y = pk2(src[128], src[192]); o.z = pk2(src[256], src[320]); o.w = pk2(src[384], src[448]);
            *(v4u*)((bf16*)(a.ws + WS_PT) + (size_t)(gg * 64 + dd) * 64 + c0) = o; }
    }
}

__device__ __forceinline__ void ln_rows(const float* Y, const float* g, const float* b, float* of, bf16* ob, int G, int bx) {
    const int tid = fresh_tid(), lane = tid & 63, wave = __builtin_amdgcn_readfirstlane(tid >> 6), gw = bx * NWAVES + wave, NGW = G * NWAVES;
    f32x4 gv[4], bv[4];
#pragma unroll
    for (int j = 0; j < 4; ++j) { gv[j] = ((const f32x4*)g)[lane + 64 * j]; bv[j] = ((const f32x4*)b)[lane + 64 * j]; }
    for (int m = gw; m < M; m += NGW) {
        const f32x4* xr = (const f32x4*)(Y + (size_t)m * DM) + lane;
        f32x4 v[4]; float s = 0.f;
#pragma unroll
        for (int j = 0; j < 4; ++j) { v[j] = xr[64 * j]; s += (v[j].x + v[j].y) + (v[j].z + v[j].w); }
        const float mean = wave_sum(s) * (1.f / DM); float s2 = 0.f;
#pragma unroll
        for (int j = 0; j < 4; ++j) { v[j] = v[j] - mean; s2 += (v[j].x * v[j].x + v[j].y * v[j].y) + (v[j].z * v[j].z + v[j].w * v[j].w); }
        const float rstd = 1.f / sqrtf(wave_sum(s2) * (1.f / DM) + LN_EPS);
        f32x4* o4 = (f32x4*)(of + (size_t)m * DM) + lane;
        unsigned long long* o8 = (unsigned long long*)(ob + (size_t)m * DM) + lane;
#pragma unroll
        for (int j = 0; j < 4; ++j) { const f32x4 o = v[j] * rstd * gv[j] + bv[j]; o4[64 * j] = o;
            o8[64 * j] = (unsigned long long)pk2(o.x, o.y) | ((unsigned long long)pk2(o.z, o.w) << 32); }
    }
}
__device__ __forceinline__ void cvt_rows(const float* X, bf16* ob, int G, int bx) {
    const int tid = fresh_tid(), lane = tid & 63, wave = __builtin_amdgcn_readfirstlane(tid >> 6), gw = bx * NWAVES + wave, NGW = G * NWAVES;
    for (int m = gw; m < M; m += NGW) {
        const f32x4* xr = (const f32x4*)(X + (size_t)m * DM) + lane;
        unsigned long long* o8 = (unsigned long long*)(ob + (size_t)m * DM) + lane;
#pragma unroll
        for (int j = 0; j < 4; ++j) { const f32x4 o = xr[64 * j]; o8[64 * j] = (unsigned long long)pk2(o.x, o.y) | ((unsigned long long)pk2(o.z, o.w) << 32); }
    }
}

typedef short bf16x8v __attribute__((ext_vector_type(8)));
typedef unsigned v2u __attribute__((ext_vector_type(2)));
__device__ __forceinline__ void mix_sgu(const Args& a, int l, int ck, int h, LAS unsigned char* lds) {
    const int tid = fresh_tid(), lane = tid & 63, wave = __builtin_amdgcn_readfirstlane(tid >> 6);
    const bf16* P = (const bf16*)(a.ws + WS_R1); bf16* MX = (bf16*)(a.ws + WS_MIX);
    const bf16* Wm = (const bf16*)(a.ws + WS_SP) + (size_t)h * CHUNK * CHUNK;
    LAS bf16* vt = (LAS bf16*)lds;
    const int row0 = ck * CHUNK;
    {
        const int s = tid >> 2, q = tid & 3;
        const v4u* src = (const v4u*)(P + (size_t)(row0 + s) * PW + PC_V + 64 * h + 16 * q);
        const v4u w0 = src[0], w1 = src[1]; float f[16]; UNPACK8(w0, f, 0); UNPACK8(w1, f, 8);
        float sm = 0.f;
#pragma unroll
        for (int j = 0; j < 16; ++j) sm += f[j];
        sm += __shfl_xor(sm, 1); sm += __shfl_xor(sm, 2);
        const float mean = sm * (1.f / 64.f); float s2 = 0.f;
#pragma unroll
        for (int j = 0; j < 16; ++j) { f[j] -= mean; s2 += f[j] * f[j]; }
        s2 += __shfl_xor(s2, 1); s2 += __shfl_xor(s2, 2);
        const float rstd = 1.f / sqrtf(s2 * (1.f / 64.f) + LN_EPS);
        const f32x4* gp = (const f32x4*)(a.sgu_ln_g + (size_t)l * SW + 64 * h + 16 * q);
#pragma unroll
        for (int j4 = 0; j4 < 4; ++j4) { const f32x4 gv = gp[j4];
            vt[(16 * q + 4 * j4 + 0) * 136 + s] = (bf16)f2bf(f[4 * j4] * rstd * gv.x); vt[(16 * q + 4 * j4 + 1) * 136 + s] = (bf16)f2bf(f[4 * j4 + 1] * rstd * gv.y);
            vt[(16 * q + 4 * j4 + 2) * 136 + s] = (bf16)f2bf(f[4 * j4 + 2] * rstd * gv.z); vt[(16 * q + 4 * j4 + 3) * 136 + s] = (bf16)f2bf(f[4 * j4 + 3] * rstd * gv.w); }
    }
    __syncthreads();
    const int fr = lane & 15, fq = lane >> 4, nk = (wave >> 1) + 1, t = 16 * wave + fr;
    f32x4 acc[4];
#pragma unroll
    for (int mt = 0; mt < 4; ++mt) acc[mt] = (f32x4){0.f, 0.f, 0.f, 0.f};
    const bf16* wrow = Wm + (size_t)t * CHUNK + 8 * fq;
    v2u uu[4];
#pragma unroll
    for (int mt = 0; mt < 4; ++mt) uu[mt] = *(const v2u*)(P + (size_t)(row0 + t) * PW + PC_U + 64 * h + 16 * mt + 4 * fq);
    const float bsp = a.b_spatial[(size_t)(l * 6 + h) * CHUNK + t];
#pragma unroll
    for (int kk = 0; kk < 4; ++kk) {
        if (kk < nk) {
            const bf16x8v bfrag = *(const bf16x8v*)(wrow + 32 * kk);
#pragma unroll
            for (int mt = 0; mt < 4; ++mt) { const bf16x8v afrag = *(const LAS bf16x8v*)(vt + (16 * mt + fr) * 136 + 32 * kk + 8 * fq);
                acc[mt] = __builtin_amdgcn_mfma_f32_16x16x32_bf16(afrag, bfrag, acc[mt], 0, 0, 0); }
        }
    }
#pragma unroll
    for (int mt = 0; mt < 4; ++mt) { v2u o;
        o.x = pk2(bflo(uu[mt].x) * (acc[mt][0] + bsp), bfhi(uu[mt].x) * (acc[mt][1] + bsp)); o.y = pk2(bflo(uu[mt].y) * (acc[mt][2] + bsp), bfhi(uu[mt].y) * (acc[mt][3] + bsp));
        *(v2u*)(MX + (size_t)(row0 + t) * DM + 640 + 64 * h + 16 * mt + 4 * fq) = o; }
}
template <int WIN> __device__ __forceinline__ void pool_window(const bf16* Pg, int row0, bool first, int tb, LAS bf16* dt, int tid) {
    const int t0 = (tid >> 3) * 2, cg = tid & 7;
    const bf16* base = Pg + (size_t)row0 * PW + 8 * cg;
    float acc[8], pf[8], p0[8], p1[8];
#pragma unroll
    for (int j = 0; j < 8; ++j) { acc[j] = 0.f; pf[j] = 0.f; p0[j] = 0.f; p1[j] = 0.f; }
#pragma unroll
    for (int j = 0; j <= WIN; ++j) {
        const int rr = t0 - WIN + 1 + j; const bool valid = !first || rr >= 0;
        v4u w = (v4u){0u, 0u, 0u, 0u};
        if (valid) w = *(const v4u*)(base + (long)rr * PW);
        float f[8]; UNPACK8(w, f, 0);
#pragma unroll
        for (int c = 0; c < 8; ++c) { if (j == 0) pf[c] = f[c]; if (j < WIN) acc[c] += f[c]; if (j == WIN - 1) p0[c] = f[c]; if (j == WIN) p1[c] = f[c]; }
    }
    const int c0 = (tb + t0 + 1) < WIN ? (tb + t0 + 1) : WIN, c1 = (tb + t0 + 2) < WIN ? (tb + t0 + 2) : WIN;
    const float r0 = 1.f / (float)c0, r1 = 1.f / (float)c1;
    float d0[8], d1[8];
#pragma unroll
    for (int c = 0; c < 8; ++c) { d0[c] = acc[c] * r0 - p0[c]; d1[c] = (acc[c] + p1[c] - pf[c]) * r1 - p1[c]; }
    v4u o0, o1;
    o0.x = pk2(d0[0], d0[1]); o0.y = pk2(d0[2], d0[3]); o0.z = pk2(d0[4], d0[5]); o0.w = pk2(d0[6], d0[7]);
    o1.x = pk2(d1[0], d1[1]); o1.y = pk2(d1[2], d1[3]); o1.z = pk2(d1[4], d1[5]); o1.w = pk2(d1[6], d1[7]);
    *(LAS v4u*)(dt + t0 * 72 + 8 * cg) = o0; *(LAS v4u*)(dt + (t0 + 1) * 72 + 8 * cg) = o1;
}
__device__ __forceinline__ void mix_pool(const Args& a, int l, int ck, int g, LAS unsigned char* lds) {
    const int tid = fresh_tid(), lane = tid & 63, wave = __builtin_amdgcn_readfirstlane(tid >> 6);
    const bf16* P = (const bf16*)(a.ws + WS_R1); bf16* MX = (bf16*)(a.ws + WS_MIX);
    const bf16* WpT = (const bf16*)(a.ws + WS_PT) + (size_t)g * 64 * 64;
    LAS bf16* dt = (LAS bf16*)lds;
    const int row0 = ck * CHUNK; const bool first = (ck % (SEQ / CHUNK)) == 0; const int tb = (ck % (SEQ / CHUNK)) * CHUNK;
    const bf16* Pg = P + PC_P + 64 * g;
    if (g == 0) pool_window<2>(Pg, row0, first, tb, dt, tid); else if (g == 1) pool_window<4>(Pg, row0, first, tb, dt, tid);
    else if (g == 2) pool_window<8>(Pg, row0, first, tb, dt, tid); else pool_window<16>(Pg, row0, first, tb, dt, tid);
    __syncthreads();
    const int fr = lane & 15, fq = lane >> 4, t = 16 * wave + fr;
    f32x4 acc[4];
#pragma unroll
    for (int mt = 0; mt < 4; ++mt) acc[mt] = (f32x4){0.f, 0.f, 0.f, 0.f};
#pragma unroll
    for (int kk = 0; kk < 2; ++kk) {
        const bf16x8v bfrag = *(const LAS bf16x8v*)(dt + t * 72 + 32 * kk + 8 * fq);
#pragma unroll
        for (int mt = 0; mt < 4; ++mt) { const bf16x8v afrag = *(const bf16x8v*)(WpT + (16 * mt + fr) * 64 + 32 * kk + 8 * fq);
            acc[mt] = __builtin_amdgcn_mfma_f32_16x16x32_bf16(afrag, bfrag, acc[mt], 0, 0, 0); }
    }
#pragma unroll
    for (int mt = 0; mt < 4; ++mt) { const f32x4 ps = *(const f32x4*)(a.pool_scale + (size_t)l * PWID + 64 * g + 16 * mt + 4 * fq); v2u o;
        o.x = pk2(acc[mt][0] * ps.x, acc[mt][1] * ps.y); o.y = pk2(acc[mt][2] * ps.z, acc[mt][3] * ps.w);
        *(v2u*)(MX + (size_t)(row0 + t) * DM + 384 + 64 * g + 16 * mt + 4 * fq) = o; }
}
__device__ __forceinline__ void mix_conv(const Args& a, int l, int ck, int hc) {
    const int tid = fresh_tid();
    const bf16* P = (const bf16*)(a.ws + WS_R1); bf16* MX = (bf16*)(a.ws + WS_MIX);
    const int row0 = ck * CHUNK; const bool first = (ck % (SEQ / CHUNK)) == 0;
    const int t = tid >> 2, q = tid & 3, cb = 64 * hc + 16 * q;
    const float* wc = a.w_conv + (size_t)l * 3 * CW + cb;
    float y[16];
#pragma unroll
    for (int j = 0; j < 16; ++j) y[j] = 0.f;
#pragma unroll
    for (int k = 0; k < 3; ++k) {
        const int rr = t - 2 + k; const bool valid = !first || rr >= 0;
        v4u x0 = (v4u){0u, 0u, 0u, 0u}, x1 = x0, g0 = x0, g1 = x0;
        if (valid) { const v4u* sx = (const v4u*)(P + (size_t)(row0 + rr) * PW + PC_XA + cb); const v4u* sg = (const v4u*)(P + (size_t)(row0 + rr) * PW + PC_GC + cb); x0 = sx[0]; x1 = sx[1]; g0 = sg[0]; g1 = sg[1]; }
        float fx[16], fg[16]; UNPACK8(x0, fx, 0); UNPACK8(x1, fx, 8); UNPACK8(g0, fg, 0); UNPACK8(g1, fg, 8);
#pragma unroll
        for (int j4 = 0; j4 < 4; ++j4) { const f32x4 wv = *(const f32x4*)(wc + k * CW + 4 * j4);
            y[4 * j4] += wv.x * fx[4 * j4] * fg[4 * j4]; y[4 * j4 + 1] += wv.y * fx[4 * j4 + 1] * fg[4 * j4 + 1]; y[4 * j4 + 2] += wv.z * fx[4 * j4 + 2] * fg[4 * j4 + 2]; y[4 * j4 + 3] += wv.w * fx[4 * j4 + 3] * fg[4 * j4 + 3]; }
    }
    const v4u* sb = (const v4u*)(P + (size_t)(row0 + t) * PW + PC_GB + cb); const v4u b0 = sb[0], b1 = sb[1]; float fb[16]; UNPACK8(b0, fb, 0); UNPACK8(b1, fb, 8);
    v4u o0, o1;
    o0.x = pk2(fb[0] * y[0], fb[1] * y[1]); o0.y = pk2(fb[2] * y[2], fb[3] * y[3]); o0.z = pk2(fb[4] * y[4], fb[5] * y[5]); o0.w = pk2(fb[6] * y[6], fb[7] * y[7]);
    o1.x = pk2(fb[8] * y[8], fb[9] * y[9]); o1.y = pk2(fb[10] * y[10], fb[11] * y[11]); o1.z = pk2(fb[12] * y[12], fb[13] * y[13]); o1.w = pk2(fb[14] * y[14], fb[15] * y[15]);
    v4u* dst = (v4u*)(MX + (size_t)(row0 + t) * DM + cb); dst[0] = o0; dst[1] = o1;
}

#define XB_TMO      128
#define XB_XCNT(j)  (256  + 64 * (j))
#define XB_XSUB(j)  (1280 + 64 * (j))
#define XB_XGEN(j)  (2304 + 64 * (j))
#define XB_TOP      3328
#define XB_TOPGEN   3392
#define XCD_BAR_WORDS 3456
#define XB_SPIN_CAP (1u << 18)

__device__ __forceinline__ unsigned xb_ld(unsigned* p)              { return __hip_atomic_load(p, __ATOMIC_RELAXED, __HIP_MEMORY_SCOPE_AGENT); }
__device__ __forceinline__ unsigned xb_add(unsigned* p, unsigned v) { return __hip_atomic_fetch_add(p, v, __ATOMIC_RELAXED, __HIP_MEMORY_SCOPE_AGENT); }
__device__ __forceinline__ unsigned xb_xcc_id() { return (unsigned)__builtin_amdgcn_s_getreg((3 << 11) | 20) & 0xFu; }
#define XB_SPIN(cond, bar) do { unsigned _sp = 0; while (cond) { __builtin_amdgcn_s_sleep(1); \
    if ((++_sp & 255u) == 0u) { if (xb_ld(&(bar)[XB_TMO])) break; if (_sp > XB_SPIN_CAP) { atomicAdd(&(bar)[XB_TMO], 1u); break; } } } } while (0)

struct XcdBarrier {
    unsigned* bar; unsigned x;
    volatile LAS unsigned* st;
};

__device__ __forceinline__ XcdBarrier xcd_barrier_post(unsigned* bar, volatile LAS unsigned* st) {
    XcdBarrier b; b.bar = bar; b.x = xb_xcc_id(); b.st = st;
    if (threadIdx.x == 0) (void)xb_add(&bar[XB_XCNT(b.x)], 1u);
    return b;
}
__device__ __forceinline__ void xcd_barrier_complete(unsigned* bar, unsigned x, unsigned& nloc, unsigned& nx) {
    const unsigned G = gridDim.x * gridDim.y * gridDim.z;
    unsigned sum, cnt, mine, sp = 0u;
    for (;;) {
        sum = 0u; cnt = 0u; mine = 0u;
#pragma unroll
        for (unsigned j = 0; j < 16; ++j) { const unsigned c = xb_ld(&bar[XB_XCNT(j)]); sum += c; cnt += (c > 0u) ? 1u : 0u; mine = (j == x) ? c : mine; }
        if (sum == G) break;
        __builtin_amdgcn_s_sleep(1);
        if ((++sp & 255u) == 0u) { if (xb_ld(&bar[XB_TMO])) break; if (sp > XB_SPIN_CAP) { atomicAdd(&bar[XB_TMO], 1u); break; } }
    }
    nloc = mine > 0u ? mine : 1u; nx = cnt > 0u ? cnt : 1u;
}

__device__ __forceinline__ void xcd_barrier(const XcdBarrier& b) {
    asm volatile("s_waitcnt vmcnt(0)" ::: "memory");
    __syncthreads();
    if (threadIdx.x == 0) {
        unsigned* bar = b.bar;
        __builtin_amdgcn_s_waitcnt(0);
        unsigned nloc = b.st[0], nx = b.st[1];
        if (nloc == 0u) { xcd_barrier_complete(bar, b.x, nloc, nx); b.st[0] = nloc; b.st[1] = nx; }
        const unsigned old = xb_add(&bar[XB_XSUB(b.x)], 1u);
        const unsigned gen = old / nloc;
        if (old + 1u == (gen + 1u) * nloc) {
            __builtin_amdgcn_fence(__ATOMIC_RELEASE, "agent");
            asm volatile("s_waitcnt vmcnt(0)" ::: "memory");
            const unsigned og = xb_add(&bar[XB_TOP], 1u);
            const unsigned tg = og / nx;
            if (og + 1u == (tg + 1u) * nx) xb_add(&bar[XB_TOPGEN], 1u);
            else XB_SPIN(xb_ld(&bar[XB_TOPGEN]) == tg, bar);
            __builtin_amdgcn_fence(__ATOMIC_ACQUIRE, "agent");
            xb_add(&bar[XB_XGEN(b.x)], 1u);
            asm volatile("s_waitcnt vmcnt(0)" ::: "memory");
        } else {
            XB_SPIN(xb_ld(&bar[XB_XGEN(b.x)]) == gen, bar);
            __builtin_amdgcn_fence(__ATOMIC_ACQUIRE, "agent");
            asm volatile("s_waitcnt vmcnt(0)" ::: "memory");
        }
    }
    __syncthreads();
}

__global__ void __launch_bounds__(NTHR, 2) fwd_mega(Args a) {
    extern __shared__ __attribute__((aligned(16))) unsigned char lds_raw[];
    cg::grid_group grid = cg::this_grid();
    LAS unsigned char* lds = (LAS unsigned char*)lds_raw;
    const int G = gridDim.x, bx = blockIdx.x;
    volatile LAS unsigned* MISC = (volatile LAS unsigned*)(lds + 131072);
    if (threadIdx.x < 64) MISC[threadIdx.x] = 0u;
    __syncthreads();
    const XcdBarrier bar = xcd_barrier_post((unsigned*)(a.ws) + 4096, MISC + 8);
#define GRID_BAR() xcd_barrier(bar)
    bf16* Wb = (bf16*)(a.ws + WS_W); bf16* AB = (bf16*)(a.ws + WS_AB); bf16* MX = (bf16*)(a.ws + WS_MIX);
    float* Y = (float*)(a.ws + WS_Y); bf16* PR = (bf16*)(a.ws + WS_R1); bf16* HH = (bf16*)(a.ws + WS_R1);

    convert_layer(a, 0, lds, G, bx);
    cvt_rows(a.x, AB, G, bx);
    grid.sync();

    for (int l = 0; l < DEPTH; ++l) {
        {   pg8::Gemm g{AB, Wb + WOFF_IN, M, PW, DM}; pg8::StaticOrder S; S.init(M, PW, G, bx);
            EpiProj E{PR, PW, 3};
            pg8::gemm_phase<EpiProj, pg8::StaticOrder, true, true>(lds, g, S, E); }
        GRID_BAR();
        {   int nl = 0;
            for (int it = bx; it < 128 * 16; it += G) {
                const int part = it >> 7, ck = it & 127;
                if (part < 6) { mix_sgu(a, l, ck, part, lds + (nl & 1) * 20480); ++nl; }
                else if (part < 10) { mix_pool(a, l, ck, part - 6, lds + (nl & 1) * 20480); ++nl; }
                else mix_conv(a, l, ck, part - 10);
            } }
        GRID_BAR();
        {   pg8::Gemm g{MX, Wb + WOFF_O, M, DM, DM}; pg8::StaticOrder S; S.init(M, DM, G, bx);
            EpiRes E{l == 0 ? a.x : a.out, Y, DM, ALPHA};
            pg8::gemm_phase<EpiRes, pg8::StaticOrder, true, true>(lds, g, S, E); }
        GRID_BAR();
        ln_rows(Y, a.ln1_g + (size_t)l * DM, a.ln1_b + (size_t)l * DM, Y, AB, G, bx);
        GRID_BAR();
        {   pg8::Gemm g{AB, Wb + WOFF_GU, M, 2 * DFF, DM}; pg8::StaticOrder S; S.init(M, 2 * DFF, G, bx);
            EpiSwiglu E{HH, DFF};
            pg8::gemm_phase<EpiSwiglu, pg8::StaticOrder, true, true>(lds, g, S, E); }
        GRID_BAR();
        {   pg8::Gemm g{HH, Wb + WOFF_DN, M, DM, DFF}; pg8::StaticOrder S; S.init(M, DM, G, bx);
            EpiRes E{Y, Y, DM, ALPHA};
            pg8::gemm_phase<EpiRes, pg8::StaticOrder, true, true>(lds, g, S, E); }
        GRID_BAR();
        ln_rows(Y, a.ln2_g + (size_t)l * DM, a.ln2_b + (size_t)l * DM, a.out, AB, G, bx);
        if (l + 1 < DEPTH) { convert_layer(a, l + 1, lds, G, bx); GRID_BAR(); }
    }
}

extern "C" void kernel_launch(void* const* d_in, const int* in_sizes, int n_in, void* d_out, int out_size, void* d_ws, size_t ws_size, hipStream_t stream) {
    static int grid = 0;
    if (grid == 0) {
        if (n_in != 15 || ws_size < WS_END) { fprintf(stderr, "kernel_launch: unexpected n_in %d / ws %zu\n", n_in, ws_size); grid = -1; return; }
        int dev = 0, cus = 0, per_cu = 0;
        (void)hipGetDevice(&dev); (void)hipDeviceGetAttribute(&cus, hipDeviceAttributeMultiprocessorCount, dev);
        (void)hipFuncSetAttribute((const void*)fwd_mega, hipFuncAttributeMaxDynamicSharedMemorySize, LDS_BYTES);
        (void)hipOccupancyMaxActiveBlocksPerMultiprocessor(&per_cu, (const void*)fwd_mega, NTHR, LDS_BYTES);
        if (per_cu < 1) { fprintf(stderr, "kernel_launch: occupancy query says %d blocks per CU\n", per_cu); per_cu = 1; }
        (void)hipGetLastError();
        grid = cus;
    }
    if (grid < 0) return;
    (void)hipMemsetAsync(d_ws, 0, 65536, stream);
    Args a{};
    a.x = (const float*)d_in[0]; a.w_in = (const float*)d_in[1]; a.w_conv = (const float*)d_in[2]; a.w_pool = (const float*)d_in[3]; a.pool_scale = (const float*)d_in[4];
    a.sgu_ln_g = (const float*)d_in[5]; a.w_spatial = (const float*)d_in[6]; a.b_spatial = (const float*)d_in[7]; a.w_o = (const float*)d_in[8];
    a.ln1_g = (const float*)d_in[9]; a.ln1_b = (const float*)d_in[10]; a.w_gate_up = (const float*)d_in[11]; a.w_down = (const float*)d_in[12];
    a.ln2_g = (const float*)d_in[13]; a.ln2_b = (const float*)d_in[14];
    a.out = (float*)d_out; a.ws = (unsigned char*)d_ws;
    void* args[] = {&a};
    hipError_t e = hipLaunchCooperativeKernel((const void*)fwd_mega, dim3(grid), dim3(NTHR), args, LDS_BYTES, stream);
    if (e != hipSuccess) fprintf(stderr, "cooperative launch failed: %s (grid %d)\n", hipGetErrorString(e), grid);
}
```

```cpp
#include <hip/hip_runtime.h>
#include <hip/hip_cooperative_groups.h>
#include <cstdio>
#include <cstdint>
namespace pg8 {
#define PG8_LAS __attribute__((address_space(3)))
typedef unsigned short bf16_t;
typedef short bf16x8 __attribute__((ext_vector_type(8)));
typedef float f32x4 __attribute__((ext_vector_type(4)));
typedef unsigned u32x4 __attribute__((ext_vector_type(4)));
constexpr int BM = 256, BK = 64, HALF = 128, HTB = HALF * BK * 2  , STAGE_BYTES = 8 * HTB, NXCD = 8, WGM = 8;

__host__ __device__ __forceinline__ int lds_byte(int r, int c) { const int st = (r >> 4) * 2 + (c >> 5), rr = r & 15, cc = c & 31, ob = rr * 64 + cc * 2; return st * 1024 + (ob ^ (((ob >> 9) & 1) << 5)); }
__host__ __device__ __forceinline__ void stage_rc(int b, int& R, int& C) { const int st = b / 1024, sb = b % 1024, swz = sb ^ (((sb >> 9) & 1) << 5); R = (st >> 1) * 16 + swz / 64; C = (st & 1) * 32 + (swz % 64) / 2; }
__host__ __device__ __forceinline__ int perm32(int rho) { const int n = rho >> 4, i = rho & 15; return 8 * (i >> 2) + 4 * n + (i & 3); }

struct Unit { int pm, pn; };
struct Gemm { const bf16_t* A; const bf16_t* Bt; int M, N, K; };

struct StaticOrder {
    int nM, nN, nwg, G, c;
    __host__ __device__ void init(int M, int N, int G_, int c_) { nM = M / BM; nN = N / BM; nwg = nM * nN; G = G_; c = c_; }
    __host__ __device__ bool next(int i, Unit& u) const {
        const long L = (long)i * G + c; if (L >= nwg) return false;
        int wgid = (int)L; { const int q = nwg / NXCD, r = nwg % NXCD, xcd = wgid % NXCD, off = wgid / NXCD; wgid = (xcd < r ? xcd * (q + 1) : r * (q + 1) + (xcd - r) * q) + off; }
        const int nig = WGM * nN, gid = wgid / nig, fm = gid * WGM, gsz = (nM - fm) < WGM ? (nM - fm) : WGM;
        u.pm = fm + ((wgid % nig) % gsz); u.pn = (wgid % nig) / gsz; return true;
    }
    __device__ __forceinline__ void a_ready(const Unit&) const {}
    __device__ __forceinline__ void done(const Unit&) const {}
    __device__ __forceinline__ bool is_half(const Unit&) const { return false; }
};

__device__ __forceinline__ unsigned cvt_pk_bf16(float lo, float hi) { unsigned r; asm volatile("v_cvt_pk_bf16_f32 %0, %1, %2" : "=v"(r) : "v"(lo), "v"(hi)); return r; }
typedef float f32x2 __attribute__((ext_vector_type(2)));
__device__ __forceinline__ f32x2 gelu_pk(f32x2 v) {
    const f32x2 av = __builtin_elementwise_abs(v), d = av * 0.2316418882f + 1.0f;
    f32x2 t; t.x = __builtin_amdgcn_rcpf(d.x); t.y = __builtin_amdgcn_rcpf(d.y);
    f32x2 q = t * 0.5307027145f + (-0.7265760135f); q = q * t + 0.7107068705f; q = q * t + (-0.142248368f); q = q * t + 0.127414796f; q = q * t;
    const f32x2 s = (v * v) * (-0.72134752044f);
    f32x2 e; e.x = __builtin_amdgcn_exp2f(s.x); e.y = __builtin_amdgcn_exp2f(s.y);
    const f32x2 m = v * (q * e), r = v - m;
    f32x2 o; o.x = v.x < 0.f ? m.x : r.x; o.y = v.y < 0.f ? m.y : r.y; return o;
}

template <int ACT  > struct EpiBf16 {
    static constexpr bool PERM = true, AFTER_DRAIN = false; static_assert(ACT == 0 || ACT == 1, "EpiBf16: ACT is 0 (none) or 1 (gelu_pk)");
    bf16_t* O; int ldc; const float* bias; int split_cols; size_t split_stride; float scale0;
    __device__ __forceinline__ void operator()(const f32x4 (&acc)[2][2][4][2], const Unit& u, int wr, int wc, int fr, int fq) const {
        const int row0 = u.pm * BM + wr * 64 + fr; int colt = u.pn * BM; bf16_t* base = O;
        float sc = 1.f; if (split_cols) { const int t = colt / split_cols; base += (size_t)t * split_stride; colt -= t * split_cols; if (t == 0) sc = scale0; }
        const int col0 = colt + wc * 32 + 8 * fq, bcol0 = u.pn * BM + wc * 32 + 8 * fq;
        f32x4 bv[2][2];
#pragma unroll
        for (int bj = 0; bj < 2; ++bj)
#pragma unroll
            for (int n = 0; n < 2; ++n) bv[bj][n] = bias ? *(const f32x4*)(bias + bcol0 + bj * HALF + 4 * n) : (f32x4){0.f, 0.f, 0.f, 0.f};
#pragma unroll
        for (int ai = 0; ai < 2; ++ai)
#pragma unroll
            for (int m = 0; m < 4; ++m) { bf16_t* rowp = base + (size_t)(row0 + ai * HALF + m * 16) * ldc + col0;
#pragma unroll
                for (int bj = 0; bj < 2; ++bj) { f32x4 v0 = acc[ai][bj][m][0] + bv[bj][0], v1 = acc[ai][bj][m][1] + bv[bj][1];
                    if (ACT == 1) { f32x2 a = gelu_pk((f32x2){v0[0], v0[1]}), b = gelu_pk((f32x2){v0[2], v0[3]}), c = gelu_pk((f32x2){v1[0], v1[1]}), d = gelu_pk((f32x2){v1[2], v1[3]});
                        v0 = (f32x4){a.x, a.y, b.x, b.y}; v1 = (f32x4){c.x, c.y, d.x, d.y}; }
                    v0 = v0 * sc; v1 = v1 * sc; u32x4 w; w.x = cvt_pk_bf16(v0[0], v0[1]); w.y = cvt_pk_bf16(v0[2], v0[3]); w.z = cvt_pk_bf16(v1[0], v1[1]); w.w = cvt_pk_bf16(v1[2], v1[3]);
                    *(u32x4*)(rowp + bj * HALF) = w; } }
    }
};

struct PanelStats {
    unsigned* xbuf;
    unsigned* cnt;
    unsigned* tmo;
    int ntn; float eps;
    unsigned code;
    unsigned gen;
    __device__ __forceinline__ bool run(const f32x4 (&v)[2][2][4][2], const Unit& u, int wr, int wc, int fr, int fq, PG8_LAS unsigned char* lds, int wid, int lane) const {
        typedef float f32x2v __attribute__((ext_vector_type(2)));
        PG8_LAS f32x2v* P = (PG8_LAS f32x2v*)lds;
        PG8_LAS f32x2v* S = (PG8_LAS f32x2v*)(lds + 8192);
        PG8_LAS unsigned* flag = (PG8_LAS unsigned*)(lds + 8192 + 2048);
#pragma unroll
        for (int ai = 0; ai < 2; ++ai)
#pragma unroll
            for (int m = 0; m < 4; ++m) {
                float s = 0.f;
#pragma unroll
                for (int bj = 0; bj < 2; ++bj)
#pragma unroll
                    for (int n = 0; n < 2; ++n) { const f32x4 x = v[ai][bj][m][n]; s += (x[0] + x[1]) + (x[2] + x[3]); }
                s += __shfl_xor(s, 16); s += __shfl_xor(s, 32);
                const float mw = s * (1.0f / 64.0f); float q = 0.f;
#pragma unroll
                for (int bj = 0; bj < 2; ++bj)
#pragma unroll
                    for (int n = 0; n < 2; ++n) { const f32x4 d = v[ai][bj][m][n] - mw; q += (d[0] * d[0] + d[1] * d[1]) + (d[2] * d[2] + d[3] * d[3]); }
                q += __shfl_xor(q, 16); q += __shfl_xor(q, 32);
                if (fq == 0) P[(ai * HALF + wr * 64 + m * 16 + fr) * 4 + wc] = (f32x2v){mw, q};
            }
        asm volatile("s_waitcnt lgkmcnt(0)" ::: "memory"); __builtin_amdgcn_s_barrier(); asm volatile("" ::: "memory");
#if defined(BROKEN_EXCHANGE_NO_WAIT)
#warning BROKEN CONTROL BUILD: the row-statistics exchange does not wait; results are wrong by design
        if (blockIdx.x >= 64) { const long long t0_ = clock64(); while (clock64() - t0_ < 60000) __builtin_amdgcn_s_sleep(8); }
#endif
        const int row = wid * 32 + (lane & 31);
        if (lane < 32) {
            const f32x2v a = P[row * 4 + 0], b = P[row * 4 + 1], c = P[row * 4 + 2], d = P[row * 4 + 3];
            const float mt = (a.x + b.x + c.x + d.x) * 0.25f;
            const float da = a.x - mt, db = b.x - mt, dc = c.x - mt, dd = d.x - mt;
            const float m2 = (a.y + b.y) + (c.y + d.y) + 64.0f * ((da * da + db * db) + (dc * dc + dd * dd));
            unsigned long long* slot = (unsigned long long*)xbuf + ((size_t)(u.pm * BM + row) * 4 + u.pn);
            __hip_atomic_store(slot, ((unsigned long long)__float_as_uint(m2) << 32) | __float_as_uint(mt), __ATOMIC_RELAXED, __HIP_MEMORY_SCOPE_AGENT);
        }
        asm volatile("s_waitcnt vmcnt(0)" ::: "memory");
        if (lane == 0) __hip_atomic_fetch_add(cnt + 64 * u.pm, 1u, __ATOMIC_RELAXED, __HIP_MEMORY_SCOPE_AGENT);
        if (wid == 0) {
            bool dead = false; const unsigned long long t0 = __builtin_amdgcn_s_memrealtime(); const unsigned want = 8u * (unsigned)ntn * (gen + 1u);
            for (;;) {
#if defined(BROKEN_EXCHANGE_NO_WAIT)
                break;
#endif
                if ((unsigned)__builtin_amdgcn_readfirstlane(__hip_atomic_load(cnt + 64 * u.pm, __ATOMIC_RELAXED, __HIP_MEMORY_SCOPE_AGENT)) >= want) break;
                if (__builtin_amdgcn_s_memrealtime() - t0 > 2000000ull) {
                    if (lane == 0) { unsigned expect = 0u; __hip_atomic_compare_exchange_strong(tmo + 1, &expect, code | (unsigned)(u.pm & 0xff), __ATOMIC_RELAXED, __ATOMIC_RELAXED, __HIP_MEMORY_SCOPE_AGENT);
                                     __hip_atomic_store(tmo, 1u, __ATOMIC_RELAXED, __HIP_MEMORY_SCOPE_AGENT); }
                    dead = true; break; }
                __builtin_amdgcn_s_sleep(2);
            }
            if (lane == 0) flag[0] = dead ? 1u : 0u;
        }
        asm volatile("s_waitcnt vmcnt(0) lgkmcnt(0)" ::: "memory"); __builtin_amdgcn_s_barrier(); asm volatile("" ::: "memory");
        const bool bad = flag[0] != 0u;
        if (lane < 32) {
            const unsigned long long* slot = (const unsigned long long*)xbuf + (size_t)(u.pm * BM + row) * 4; float mt[4], m2[4]; float ms = 0.f;
#pragma unroll
            for (int t = 0; t < 4; ++t) { if (t < ntn) { const unsigned long long w = __hip_atomic_load(slot + t, __ATOMIC_RELAXED, __HIP_MEMORY_SCOPE_AGENT); mt[t] = __uint_as_float((unsigned)w); m2[t] = __uint_as_float((unsigned)(w >> 32)); } else { mt[t] = 0.f; m2[t] = 0.f; } ms += mt[t]; }
            const float mean = ms / (float)ntn; float q = 0.f;
#pragma unroll
            for (int t = 0; t < 4; ++t) if (t < ntn) { const float dm = mt[t] - mean; q += m2[t] + 256.0f * dm * dm; }
            S[row] = (f32x2v){mean, 1.0f / sqrtf(q / (256.0f * (float)ntn) + eps)};
        }
        asm volatile("s_waitcnt lgkmcnt(0)" ::: "memory"); __builtin_amdgcn_s_barrier(); asm volatile("" ::: "memory");
        return bad;
    }
};
struct EpiLnRes {
    static constexpr bool PERM = false, AFTER_DRAIN = true;
    const float* base; float* out; int ldc; const float* bias; PanelStats st; unsigned poison;
    __device__ __forceinline__ void fused(f32x4 (&acc)[2][2][4][2], const Unit& u, int wr, int wc, int fr, int fq, PG8_LAS unsigned char* lds, int wid, int lane) const {
        typedef float f32x2v __attribute__((ext_vector_type(2)));
        const PG8_LAS f32x2v* S = (const PG8_LAS f32x2v*)(lds + 8192);
        const int col0 = u.pn * BM + wc * 32 + 4 * fq;
#pragma unroll
        for (int bj = 0; bj < 2; ++bj)
#pragma unroll
            for (int n = 0; n < 2; ++n) { const f32x4 bv = bias ? *(const f32x4*)(bias + col0 + bj * HALF + n * 16) : (f32x4){0.f, 0.f, 0.f, 0.f};
#pragma unroll
                for (int ai = 0; ai < 2; ++ai)
#pragma unroll
                    for (int m = 0; m < 4; ++m) acc[ai][bj][m][n] += bv; }
        f32x4 pre[4][2][2];
#pragma unroll
        for (int m = 0; m < 4; ++m) { const size_t off = (size_t)(u.pm * BM + wr * 64 + m * 16 + fr) * ldc + col0;
#pragma unroll
            for (int bj = 0; bj < 2; ++bj)
#pragma unroll
                for (int n = 0; n < 2; ++n) pre[m][bj][n] = *(const f32x4*)(base + off + bj * HALF + n * 16); }
        const bool bad = st.run(acc, u, wr, wc, fr, fq, lds, wid, lane) || poison != 0u;
        const float qnan = __builtin_nanf("");
#pragma unroll
        for (int ai = 0; ai < 2; ++ai)
#pragma unroll
            for (int m = 0; m < 4; ++m) { const int r = ai * HALF + wr * 64 + m * 16 + fr; const f32x2v sr = S[r]; const size_t off = (size_t)(u.pm * BM + r) * ldc + col0;
#pragma unroll
                for (int bj = 0; bj < 2; ++bj)
#pragma unroll
                    for (int n = 0; n < 2; ++n) { const f32x4 bs = ai == 0 ? pre[m][bj][n] : *(const f32x4*)(base + off + bj * HALF + n * 16); f32x4 o = bs + (acc[ai][bj][m][n] - sr.x) * sr.y;
                        if (bad) o = (f32x4){qnan, qnan, qnan, qnan}; *(f32x4*)(out + off + bj * HALF + n * 16) = o; }
                if (m & 1) asm volatile("" ::: "memory"); }
    }
};
struct EpiLnResLn {
    static constexpr bool PERM = false, AFTER_DRAIN = true;
    const float* base; float* out; bf16_t* xn; int ldc; const float* bias; PanelStats st1, st2; unsigned poison;
    __device__ __forceinline__ void fused(f32x4 (&acc)[2][2][4][2], const Unit& u, int wr, int wc, int fr, int fq, PG8_LAS unsigned char* lds, int wid, int lane) const {
        typedef float f32x2v __attribute__((ext_vector_type(2))); typedef unsigned u32x2v __attribute__((ext_vector_type(2)));
        const PG8_LAS f32x2v* S = (const PG8_LAS f32x2v*)(lds + 8192);
        const int col0 = u.pn * BM + wc * 32 + 4 * fq;
#pragma unroll
        for (int bj = 0; bj < 2; ++bj)
#pragma unroll
            for (int n = 0; n < 2; ++n) { const f32x4 bv = bias ? *(const f32x4*)(bias + col0 + bj * HALF + n * 16) : (f32x4){0.f, 0.f, 0.f, 0.f};
#pragma unroll
                for (int ai = 0; ai < 2; ++ai)
#pragma unroll
                    for (int m = 0; m < 4; ++m) acc[ai][bj][m][n] += bv; }
        bool bad = st1.run(acc, u, wr, wc, fr, fq, lds, wid, lane) || poison != 0u;
        const float qnan = __builtin_nanf("");
#pragma unroll
        for (int ai = 0; ai < 2; ++ai)
#pragma unroll
            for (int m = 0; m < 4; ++m) { const int r = ai * HALF + wr * 64 + m * 16 + fr; const f32x2v sr = S[r]; const size_t off = (size_t)(u.pm * BM + r) * ldc + col0;
#pragma unroll
                for (int bj = 0; bj < 2; ++bj)
#pragma unroll
                    for (int n = 0; n < 2; ++n) { const f32x4 bs = *(const f32x4*)(base + off + bj * HALF + n * 16); acc[ai][bj][m][n] = bs + (acc[ai][bj][m][n] - sr.x) * sr.y; }
                asm volatile("" : "+v"(acc[ai][0][m][0]), "+v"(acc[ai][0][m][1]), "+v"(acc[ai][1][m][0]), "+v"(acc[ai][1][m][1]));
                if (m & 1) asm volatile("" ::: "memory"); }
        const bool bad1 = bad;
        bad = st2.run(acc, u, wr, wc, fr, fq, lds, wid, lane) || bad;
#pragma unroll
        for (int ai = 0; ai < 2; ++ai)
#pragma unroll
            for (int m = 0; m < 4; ++m) { const int r = ai * HALF + wr * 64 + m * 16 + fr; const f32x2v sr = S[r]; const size_t off = (size_t)(u.pm * BM + r) * ldc + col0;
#pragma unroll
                for (int bj = 0; bj < 2; ++bj)
#pragma unroll
                    for (int n = 0; n < 2; ++n) { const f32x4 x1 = acc[ai][bj][m][n]; *(f32x4*)(out + off + bj * HALF + n * 16) = bad1 ? (f32x4){qnan, qnan, qnan, qnan} : x1;
                        const f32x4 o = (x1 - sr.x) * sr.y; u32x2v w; w.x = cvt_pk_bf16(o[0], o[1]); w.y = cvt_pk_bf16(o[2], o[3]);
                        if (bad) { w.x = 0x7fc07fc0u; w.y = 0x7fc07fc0u; } *(u32x2v*)(xn + off + bj * HALF + n * 16) = w; }
                asm volatile("" ::: "memory"); }
    }
};

template <class Epi, class Sched, bool ALIGN_EPI = false, bool SP2 = false>
__device__ __forceinline__ void gemm_phase(PG8_LAS unsigned char* lds, const Gemm g, const Sched& S, const Epi& E) {
    int tid_ = threadIdx.x; asm volatile("" : "+v"(tid_));
    const int tid = tid_, wid = __builtin_amdgcn_readfirstlane(tid >> 6), lane = tid & 63, wr = wid >> 2, wc = wid & 3, fr = lane & 15, fq = lane >> 4;
    const int K = g.K, nt = K / BK;
    unsigned voffA[2], voffB[2];
#pragma unroll
    for (int i = 0; i < 2; ++i) { int R, C; stage_rc(tid * 16 + i * 8192, R, C); const int Rb = Epi::PERM ? ((R & ~31) + perm32(R & 31)) : R;
        voffA[i] = (unsigned)(R * K + C) * 2u; voffB[i] = (unsigned)(Rb * K + C) * 2u; }
    const size_t kstep = (size_t)(BK * 2);
    const size_t hstep = (size_t)HALF * K * 2;
    const size_t tstep = 2 * hstep;
    const unsigned ldsw = (unsigned)wid * 1024u;
    const int aoff = lds_byte(wr * 64 + fr, fq * 8), boff = lds_byte(wc * 32 + fr, fq * 8);
#define PG8_SA(b, h) (((b) * 2 + (h)) * HTB)
#define PG8_SB(b, h) ((4 + (b) * 2 + (h)) * HTB)
#define PG8_STAGE(bufoff, gbase, voff) do { _Pragma("unroll") for (int _i = 0; _i < 2; ++_i) \
        __builtin_amdgcn_global_load_lds((const unsigned*)((const char*)(gbase) + (voff)[_i]), (PG8_LAS unsigned*)(lds + (bufoff) + ldsw + _i * 8192), 16, 0, 0); } while (0)
#define PG8_LDA(dst, b, h) do { _Pragma("unroll") for (int m = 0; m < 4; ++m) _Pragma("unroll") for (int k = 0; k < 2; ++k) dst[m][k] = *(const PG8_LAS bf16x8*)(lds + PG8_SA(b, h) + aoff + m * 2048 + k * 1024); } while (0)
#define PG8_LDB(dst, b, h) do { _Pragma("unroll") for (int n = 0; n < 2; ++n) _Pragma("unroll") for (int k = 0; k < 2; ++k) dst[n][k] = *(const PG8_LAS bf16x8*)(lds + PG8_SB(b, h) + boff + n * 2048 + k * 1024); } while (0)
#define PG8_MMA(ai, bj, At, Bt) do { __builtin_amdgcn_s_setprio(1); _Pragma("unroll") for (int m = 0; m < 4; ++m) _Pragma("unroll") for (int n = 0; n < 2; ++n) _Pragma("unroll") for (int k = 0; k < 2; ++k) \
        acc[ai][bj][m][n] = __builtin_amdgcn_mfma_f32_16x16x32_bf16(Bt[n][k], At[m][k], acc[ai][bj][m][n], 0, 0, 0); __builtin_amdgcn_s_setprio(0); } while (0)
#define PG8_WAIT_V(n) asm volatile("s_waitcnt vmcnt(" #n ")" ::: "memory")
#define PG8_WAIT_L(n) asm volatile("s_waitcnt lgkmcnt(" #n ")" ::: "memory")
#define PG8_BAR __builtin_amdgcn_s_barrier()
#define PG8_SCHED __builtin_amdgcn_sched_barrier(0)
    Unit cur, nxt; int ui = 0;
    if (!S.next(0, cur)) return;
    bool hb = S.is_half(cur);
    f32x4 acc[2][2][4][2];
#pragma unroll
    for (int a = 0; a < 2; ++a)
#pragma unroll
        for (int b = 0; b < 2; ++b)
#pragma unroll
            for (int m = 0; m < 4; ++m)
#pragma unroll
                for (int n = 0; n < 2; ++n) acc[a][b][m][n] = (f32x4){0.f, 0.f, 0.f, 0.f};
    bf16x8 At[4][2], B0[2][2], B1[2][2];
    const char* cA = (const char*)g.A + (size_t)cur.pm * tstep; const char* cB = (const char*)g.Bt + (size_t)cur.pn * tstep;
    S.a_ready(cur);
    if constexpr (SP2) {
        PG8_STAGE(PG8_SB(0, 0), cB, voffB); PG8_STAGE(PG8_SB(0, 1), cB + hstep, voffB); PG8_STAGE(PG8_SA(0, 0), cA, voffA); PG8_STAGE(PG8_SA(0, 1), cA + hstep, voffA);
        if (wr == 1) PG8_BAR;
        PG8_WAIT_V(2); PG8_BAR;
        PG8_STAGE(PG8_SB(1, 0), cB + kstep, voffB); PG8_STAGE(PG8_SA(1, 0), cA + kstep, voffA); PG8_STAGE(PG8_SB(1, 1), cB + hstep + kstep, voffB);
        PG8_WAIT_V(6); PG8_BAR;
    } else {
        PG8_STAGE(PG8_SB(0, 0), cB, voffB); PG8_STAGE(PG8_SA(0, 0), cA, voffA); PG8_STAGE(PG8_SB(0, 1), cB + hstep, voffB); PG8_STAGE(PG8_SA(0, 1), cA + hstep, voffA);
        if (wr == 1) PG8_BAR;
        PG8_WAIT_V(4); PG8_BAR;
        PG8_STAGE(PG8_SB(1, 0), cB + kstep, voffB); PG8_STAGE(PG8_SA(1, 0), cA + kstep, voffA); PG8_STAGE(PG8_SB(1, 1), cB + hstep + kstep, voffB);
        PG8_WAIT_V(6); PG8_BAR;
    }
    for (;;) {
        const bool has_next = S.next(ui + 1, nxt);
        const char* nA = has_next ? (const char*)g.A + (size_t)nxt.pm * tstep : cA; const char* nB = has_next ? (const char*)g.Bt + (size_t)nxt.pn * tstep : cB;
        for (int t = 0; t < nt; t += 2) {
            const bool last = (t == nt - 2);
            const char* a1 = cA + (size_t)(t + 1) * kstep;
            const char* a2 = last ? nA : cA + (size_t)(t + 2) * kstep; const char* b2 = last ? nB : cB + (size_t)(t + 2) * kstep;
            const char* a3 = a2 + kstep; const char* b3 = b2 + kstep;
            if (last && has_next) S.a_ready(nxt);
            if constexpr (SP2) {
            PG8_LDB(B0, 0, 0); PG8_LDB(B1, 0, 1); PG8_SCHED; PG8_LDA(At, 0, 0); PG8_STAGE(PG8_SA(1, 1), a1 + hstep, voffA);
            PG8_WAIT_V(8); PG8_WAIT_L(0); PG8_BAR; PG8_MMA(0, 0, At, B0); if (!hb) PG8_MMA(0, 1, At, B1); PG8_BAR; PG8_SCHED;
            PG8_LDA(At, 0, 1); PG8_STAGE(PG8_SB(0, 0), b2, voffB); PG8_STAGE(PG8_SB(0, 1), b2 + hstep, voffB); PG8_STAGE(PG8_SA(0, 0), a2, voffA);
            PG8_WAIT_V(8); PG8_WAIT_L(0); PG8_BAR; PG8_MMA(1, 0, At, B0); if (!hb) PG8_MMA(1, 1, At, B1); PG8_BAR; PG8_SCHED;
            PG8_LDB(B0, 1, 0); PG8_LDB(B1, 1, 1); PG8_SCHED; PG8_LDA(At, 1, 0); PG8_STAGE(PG8_SA(0, 1), a2 + hstep, voffA);
            PG8_WAIT_V(8); PG8_WAIT_L(0); PG8_BAR; PG8_MMA(0, 0, At, B0); if (!hb) PG8_MMA(0, 1, At, B1); PG8_BAR; PG8_SCHED;
            PG8_LDA(At, 1, 1); PG8_STAGE(PG8_SB(1, 0), b3, voffB); PG8_STAGE(PG8_SB(1, 1), b3 + hstep, voffB); PG8_STAGE(PG8_SA(1, 0), a3, voffA);
            PG8_WAIT_V(8); PG8_WAIT_L(0); PG8_BAR; PG8_MMA(1, 0, At, B0); if (!hb) PG8_MMA(1, 1, At, B1); PG8_BAR; PG8_SCHED;
            } else {
            PG8_LDB(B0, 0, 0); PG8_SCHED; PG8_LDA(At, 0, 0); PG8_STAGE(PG8_SA(1, 1), a1 + hstep, voffA);
            PG8_WAIT_L(8); PG8_BAR; PG8_WAIT_L(0); PG8_MMA(0, 0, At, B0); PG8_BAR; PG8_SCHED;
            PG8_LDB(B1, 0, 1); PG8_STAGE(PG8_SB(0, 0), b2, voffB);
            PG8_BAR; PG8_WAIT_L(0); PG8_MMA(0, 1, At, B1); PG8_BAR;
            PG8_LDA(At, 0, 1); PG8_STAGE(PG8_SA(0, 0), a2, voffA);
            PG8_BAR; PG8_WAIT_L(0); PG8_MMA(1, 0, At, B0); PG8_BAR; PG8_SCHED;
            PG8_STAGE(PG8_SB(0, 1), b2 + hstep, voffB);
            PG8_WAIT_V(6); PG8_BAR; PG8_MMA(1, 1, At, B1); PG8_BAR;
            PG8_LDB(B0, 1, 0); PG8_SCHED; PG8_LDA(At, 1, 0); PG8_STAGE(PG8_SA(0, 1), a2 + hstep, voffA);
            PG8_WAIT_L(8); PG8_BAR; PG8_WAIT_L(0); PG8_MMA(0, 0, At, B0); PG8_BAR; PG8_SCHED;
            PG8_LDB(B1, 1, 1); PG8_STAGE(PG8_SB(1, 0), b3, voffB);
            PG8_BAR; PG8_WAIT_L(0); PG8_MMA(0, 1, At, B1); PG8_BAR;
            PG8_LDA(At, 1, 1); PG8_STAGE(PG8_SA(1, 0), a3, voffA);
            PG8_BAR; PG8_WAIT_L(0); PG8_MMA(1, 0, At, B0); PG8_BAR; PG8_SCHED;
            PG8_STAGE(PG8_SB(1, 1), b3 + hstep, voffB);
            PG8_WAIT_V(6); PG8_BAR; PG8_MMA(1, 1, At, B1); PG8_BAR;
            }
        }
        if constexpr (ALIGN_EPI) { if (wr == 0) PG8_BAR; }
        if constexpr (!Epi::AFTER_DRAIN) { E(acc, cur, wr, wc, fr, fq); S.done(cur); }
        if (!has_next) break;
#pragma unroll
        for (int a = 0; a < 2; ++a)
#pragma unroll
            for (int b = 0; b < 2; ++b)
#pragma unroll
                for (int m = 0; m < 4; ++m)
#pragma unroll
                    for (int n = 0; n < 2; ++n) acc[a][b][m][n] = (f32x4){0.f, 0.f, 0.f, 0.f};
        cur = nxt; cA = nA; cB = nB; ++ui; hb = S.is_half(cur);
        if constexpr (ALIGN_EPI) { if (wr == 1) PG8_BAR; }
    }
    PG8_WAIT_V(0);
    if constexpr (!ALIGN_EPI) { if (wr == 0) PG8_BAR; }
    PG8_BAR;
    if constexpr (Epi::AFTER_DRAIN) { E.fused(acc, cur, wr, wc, fr, fq, lds, wid, lane); S.done(cur); }
#undef PG8_SA
#undef PG8_SB
#undef PG8_STAGE
#undef PG8_LDA
#undef PG8_LDB
#undef PG8_MMA
#undef PG8_WAIT_V
#undef PG8_WAIT_L
#undef PG8_BAR
#undef PG8_SCHED
}
}

namespace cg = cooperative_groups;
#define LAS __attribute__((address_space(3)))
typedef unsigned short bf16;
typedef unsigned v4u __attribute__((ext_vector_type(4)));
typedef float f32x4 __attribute__((ext_vector_type(4)));
typedef const __attribute__((address_space(4))) float cfloat;

constexpr int NWAVES = 8, NTHR = 512;
constexpr int DM = 1024, BATCH = 8, SEQ = 2048, DEPTH = 4, M = BATCH * SEQ;
constexpr int CW = 384, PWID = 256, SW = 384, INW = 2176, PW = 2304  , DFF = 2816, CHUNK = 128;
constexpr float LN_EPS = 1e-5f;
constexpr float ALPHA = 1.681792830507429f;
constexpr int PC_U = 0, PC_V = 384, PC_XA = 768, PC_GB = 1152, PC_GC = 1536, PC_P = 1920;
constexpr size_t MiB = 1u << 20;
constexpr size_t WS_W = 1 * MiB, WS_AB = 24 * MiB, WS_MIX = 56 * MiB, WS_Y = 88 * MiB, WS_R1 = 152 * MiB, WS_END = 240 * MiB;
constexpr size_t WOFF_IN = 0, WOFF_O = (size_t)PW * DM, WOFF_GU = WOFF_O + (size_t)DM * DM, WOFF_DN = WOFF_GU + (size_t)2 * DFF * DM;
static_assert((WOFF_DN + (size_t)DM * DFF) * 2 + WS_W <= WS_AB, "weights fit");
constexpr size_t WS_CNT = 32768, WS_XCH = 524288;
constexpr size_t WS_SP = 65536;
constexpr size_t WS_PT = WS_SP + 6 * 128 * 128 * 2;
static_assert(WS_PT + 4 * 64 * 64 * 2 <= WS_W, "small weights fit");
constexpr int LDS_BYTES = 147456;

__device__ __forceinline__ unsigned f2bf(float f) { unsigned u = __builtin_bit_cast(unsigned, f); return (u + 0x7fffu + ((u >> 16) & 1u)) >> 16; }
__device__ __forceinline__ unsigned pk2(float lo, float hi) { return f2bf(lo) | (f2bf(hi) << 16); }
__device__ __forceinline__ float bflo(unsigned w) { return __builtin_bit_cast(float, w << 16); }
__device__ __forceinline__ float bfhi(unsigned w) { return __builtin_bit_cast(float, w & 0xffff0000u); }
__device__ __forceinline__ float wave_sum(float v) {
#pragma unroll
    for (int o = 1; o < 64; o <<= 1) v += __shfl_xor(v, o);
    return v;
}
#define UNPACK8(V_, f, o) do { f[o+0] = bflo((V_).x); f[o+1] = bfhi((V_).x); f[o+2] = bflo((V_).y); f[o+3] = bfhi((V_).y); f[o+4] = bflo((V_).z); f[o+5] = bfhi((V_).z); f[o+6] = bflo((V_).w); f[o+7] = bfhi((V_).w); } while (0)

__device__ __forceinline__ int fresh_tid() { int t = threadIdx.x; asm volatile("" : "+v"(t)); return t; }
__device__ __forceinline__ void store16_wt(void* p, pg8::u32x4 w) { asm volatile("global_store_dwordx4 %0, %1, off sc1\n\ts_nop 1" :: "v"(p), "v"(w) : "memory"); }
struct Args {
    const float *x, *w_in, *w_conv, *w_pool, *pool_scale, *sgu_ln_g, *w_spatial, *b_spatial, *w_o, *ln1_g, *ln1_b, *w_gate_up, *w_down, *ln2_g, *ln2_b;
    float* out; unsigned char* ws;
};

struct ProjOrder {
    pg8::StaticOrder so; int G, c;
    __device__ void init(int G_, int c_) { so.init(M, 2048, G_, c_); G = G_; c = c_; }
    __device__ bool next(int i, pg8::Unit& u) const { const long L = (long)i * G + c; if (L < 512) return so.next(i, u); const int j = (int)(L - 512); if (j >= 64) return false; u.pm = 8 * (j & 7) + (j >> 3); u.pn = 8; return true; }
    __device__ __forceinline__ void a_ready(const pg8::Unit&) const {}
    __device__ __forceinline__ void done(const pg8::Unit&) const {}
    __device__ __forceinline__ bool is_half(const pg8::Unit& u) const { return u.pn == 8; }
};
struct EpiProj {
    static constexpr bool PERM = true, AFTER_DRAIN = false;
    bf16* O; int ldc; int gelu_tiles;
    __device__ __forceinline__ void operator()(const pg8::f32x4 (&acc)[2][2][4][2], const pg8::Unit& u, int wr, int wc, int fr, int fq) const {
        using namespace pg8;
        const int row0 = u.pm * BM + wr * 64 + fr, col0 = u.pn * BM + wc * 32 + 8 * fq;
        const bool act = u.pn < gelu_tiles;
#pragma unroll
        for (int ai = 0; ai < 2; ++ai)
#pragma unroll
            for (int m = 0; m < 4; ++m) { bf16* rowp = O + (size_t)(row0 + ai * HALF + m * 16) * ldc + col0;
#pragma unroll
                for (int bj = 0; bj < 2; ++bj) { pg8::f32x4 v0 = acc[ai][bj][m][0], v1 = acc[ai][bj][m][1];
                    if (act) { f32x2 a = gelu_pk((f32x2){v0[0], v0[1]}), b = gelu_pk((f32x2){v0[2], v0[3]}), c = gelu_pk((f32x2){v1[0], v1[1]}), d = gelu_pk((f32x2){v1[2], v1[3]});
                        v0 = (pg8::f32x4){a.x, a.y, b.x, b.y}; v1 = (pg8::f32x4){c.x, c.y, d.x, d.y}; }
                    u32x4 w; w.x = cvt_pk_bf16(v0[0], v0[1]); w.y = cvt_pk_bf16(v0[2], v0[3]); w.z = cvt_pk_bf16(v1[0], v1[1]); w.w = cvt_pk_bf16(v1[2], v1[3]);
                    store16_wt(rowp + bj * HALF, w); } }
    }
};
struct EpiRes {
    static constexpr bool PERM = false, AFTER_DRAIN = false;
    const float* X; float* Y; int ldc; float alpha;
    __device__ __forceinline__ void operator()(const pg8::f32x4 (&acc)[2][2][4][2], const pg8::Unit& u, int wr, int wc, int fr, int fq) const {
        using namespace pg8;
        const int row0 = u.pm * BM + wr * 64 + fr, col0 = u.pn * BM + wc * 32 + 4 * fq;
#pragma unroll
        for (int ai = 0; ai < 2; ++ai)
#pragma unroll
            for (int m = 0; m < 4; ++m) { const size_t off = (size_t)(row0 + ai * HALF + m * 16) * ldc + col0;
#pragma unroll
                for (int bj = 0; bj < 2; ++bj)
#pragma unroll
                    for (int n = 0; n < 2; ++n) { const pg8::f32x4 xv = *(const pg8::f32x4*)(X + off + bj * HALF + n * 16);
                        *(pg8::f32x4*)(Y + off + bj * HALF + n * 16) = xv * alpha + acc[ai][bj][m][n]; }
                asm volatile("" ::: "memory"); }
    }
};
struct PanelStats2 {
    unsigned long long* slots; int ntn; float eps; unsigned tag;
    __device__ __forceinline__ void run(const pg8::f32x4 (&v)[2][2][4][2], const pg8::Unit& u, int wr, int wc, int fr, int fq, LAS unsigned char* lds, int wid, int lane) const {
        using namespace pg8;
        typedef float f32x2v __attribute__((ext_vector_type(2)));
        LAS f32x2v* P = (LAS f32x2v*)lds;
        LAS f32x2v* S = (LAS f32x2v*)(lds + 8192);
#pragma unroll
        for (int ai = 0; ai < 2; ++ai)
#pragma unroll
            for (int m = 0; m < 4; ++m) {
                float s = 0.f;
#pragma unroll
                for (int bj = 0; bj < 2; ++bj)
#pragma unroll
                    for (int n = 0; n < 2; ++n) { const pg8::f32x4 x = v[ai][bj][m][n]; s += (x[0] + x[1]) + (x[2] + x[3]); }
                s += __shfl_xor(s, 16); s += __shfl_xor(s, 32);
                const float mw = s * (1.0f / 64.0f); float q = 0.f;
#pragma unroll
                for (int bj = 0; bj < 2; ++bj)
#pragma unroll
                    for (int n = 0; n < 2; ++n) { const pg8::f32x4 d = v[ai][bj][m][n] - mw; q += (d[0] * d[0] + d[1] * d[1]) + (d[2] * d[2] + d[3] * d[3]); }
                q += __shfl_xor(q, 16); q += __shfl_xor(q, 32);
                if (fq == 0) P[(ai * HALF + wr * 64 + m * 16 + fr) * 4 + wc] = (f32x2v){mw, q};
            }
        asm volatile("s_waitcnt lgkmcnt(0)" ::: "memory"); __builtin_amdgcn_s_barrier(); asm volatile("" ::: "memory");
        if (lane < 32) {
            const int row = wid * 32 + lane;
            const f32x2v a = P[row * 4 + 0], b = P[row * 4 + 1], c = P[row * 4 + 2], d = P[row * 4 + 3];
            const float mt = (a.x + b.x + c.x + d.x) * 0.25f;
            const float da = a.x - mt, db = b.x - mt, dc = c.x - mt, dd = d.x - mt;
            const float m2 = (a.y + b.y) + (c.y + d.y) + 64.0f * ((da * da + db * db) + (dc * dc + dd * dd));
            unsigned long long* sl = slots + (size_t)(u.pm * BM + row) * 8;
            const unsigned long long th = (unsigned long long)tag << 32;
            __hip_atomic_store(sl + 2 * u.pn, th | __float_as_uint(mt), __ATOMIC_RELAXED, __HIP_MEMORY_SCOPE_AGENT);
            __hip_atomic_store(sl + 2 * u.pn + 1, th | __float_as_uint(m2), __ATOMIC_RELAXED, __HIP_MEMORY_SCOPE_AGENT);
            float mts[4], m2s[4]; unsigned pending = 0u;
#pragma unroll
            for (int tt = 0; tt < 4; ++tt) { mts[tt] = mt; m2s[tt] = m2; if (tt < ntn && tt != u.pn) pending |= 1u << tt; }
            unsigned spins = 0u;
            while (pending) {
#pragma unroll
                for (int tt = 0; tt < 4; ++tt) if (pending & (1u << tt)) {
                    const unsigned long long w0 = __hip_atomic_load(sl + 2 * tt, __ATOMIC_RELAXED, __HIP_MEMORY_SCOPE_AGENT), w1 = __hip_atomic_load(sl + 2 * tt + 1, __ATOMIC_RELAXED, __HIP_MEMORY_SCOPE_AGENT);
                    if ((unsigned)(w0 >> 32) == tag && (unsigned)(w1 >> 32) == tag) { mts[tt] = __uint_as_float((unsigned)w0); m2s[tt] = __uint_as_float((unsigned)w1); pending &= ~(1u << tt); } }
                if (pending) { __builtin_amdgcn_s_sleep(1); if (++spins > (1u << 14)) { mts[0] = __builtin_nanf(""); break; } }
            }
            float ms = 0.f;
#pragma unroll
            for (int tt = 0; tt < 4; ++tt) if (tt < ntn) ms += mts[tt];
            const float mean = ms / (float)ntn; float q = 0.f;
#pragma unroll
            for (int tt = 0; tt < 4; ++tt) if (tt < ntn) { const float dm = mts[tt] - mean; q += m2s[tt] + 256.0f * dm * dm; }
            S[row] = (f32x2v){mean, 1.0f / sqrtf(q / (256.0f * (float)ntn) + eps)};
        }
        asm volatile("s_waitcnt lgkmcnt(0)" ::: "memory"); __builtin_amdgcn_s_barrier(); asm volatile("" ::: "memory");
    }
};
struct EpiResLn {
    static constexpr bool PERM = true, AFTER_DRAIN = true;
    const bf16* Xb; float* Of; bf16* Ob; const float* g; const float* b; int ldc; float alpha; PanelStats2 st;
    __device__ __forceinline__ void fused(pg8::f32x4 (&acc)[2][2][4][2], const pg8::Unit& u, int wr, int wc, int fr, int fq, LAS unsigned char* lds, int wid, int lane) const {
        using namespace pg8;
        typedef float f32x2v __attribute__((ext_vector_type(2)));
        const LAS f32x2v* S = (const LAS f32x2v*)(lds + 8192);
        const int col0 = u.pn * BM + wc * 32 + 8 * fq;
#pragma unroll
        for (int ai = 0; ai < 2; ++ai) {
#pragma unroll
            for (int m = 0; m < 4; ++m) { const size_t off = (size_t)(u.pm * BM + ai * HALF + wr * 64 + m * 16 + fr) * ldc + col0;
#pragma unroll
                for (int bj = 0; bj < 2; ++bj) { const u32x4 xw = *(const u32x4*)(Xb + off + bj * HALF);
                    acc[ai][bj][m][0] = (pg8::f32x4){bflo(xw.x), bfhi(xw.x), bflo(xw.y), bfhi(xw.y)} * alpha + acc[ai][bj][m][0];
                    acc[ai][bj][m][1] = (pg8::f32x4){bflo(xw.z), bfhi(xw.z), bflo(xw.w), bfhi(xw.w)} * alpha + acc[ai][bj][m][1]; }
                asm volatile("" : "+v"(acc[ai][0][m][0]), "+v"(acc[ai][0][m][1]), "+v"(acc[ai][1][m][0]), "+v"(acc[ai][1][m][1])); } }
        pg8::f32x4 gv[2][2], bv[2][2];
#pragma unroll
        for (int bj = 0; bj < 2; ++bj)
#pragma unroll
            for (int n = 0; n < 2; ++n) { gv[bj][n] = *(const pg8::f32x4*)(g + col0 + bj * HALF + n * 4); bv[bj][n] = *(const pg8::f32x4*)(b + col0 + bj * HALF + n * 4); }
        st.run(acc, u, wr, wc, fr, fq, lds, wid, lane);
        const bool wf = Of != nullptr;
#pragma unroll
        for (int ai = 0; ai < 2; ++ai)
#pragma unroll
            for (int m = 0; m < 4; ++m) { const int r = ai * HALF + wr * 64 + m * 16 + fr; const f32x2v sr = S[r]; const size_t off = (size_t)(u.pm * BM + r) * ldc + col0;
#pragma unroll
                for (int bj = 0; bj < 2; ++bj) {
                    pg8::f32x4 o0 = (acc[ai][bj][m][0] - sr.x) * sr.y * gv[bj][0] + bv[bj][0], o1 = (acc[ai][bj][m][1] - sr.x) * sr.y * gv[bj][1] + bv[bj][1];
                    if (wf) { *(pg8::f32x4*)(Of + off + bj * HALF) = o0; *(pg8::f32x4*)(Of + off + bj * HALF + 4) = o1; }
                    else { u32x4 w; w.x = cvt_pk_bf16(o0[0], o0[1]); w.y = cvt_pk_bf16(o0[2], o0[3]); w.z = cvt_pk_bf16(o1[0], o1[1]); w.w = cvt_pk_bf16(o1[2], o1[3]);
                        asm volatile("global_store_dwordx4 %0, %1, off sc1\n\ts_nop 1" :: "v"(Ob + off + bj * HALF), "v"(w) : "memory"); } } }
    }
};
struct EpiSwiglu {
    static constexpr bool PERM = true, AFTER_DRAIN = false;
    bf16* H; int ldc;
    __device__ __forceinline__ void operator()(const pg8::f32x4 (&acc)[2][2][4][2], const pg8::Unit& u, int wr, int wc, int fr, int fq) const {
        using namespace pg8;
        const int row0 = u.pm * BM + wr * 64 + fr, col0 = u.pn * HALF + wc * 32 + 8 * fq;
#pragma unroll
        for (int ai = 0; ai < 2; ++ai)
#pragma unroll
            for (int m = 0; m < 4; ++m) { bf16* rowp = H + (size_t)(row0 + ai * HALF + m * 16) * ldc + col0;
                float h[8];
#pragma unroll
                for (int n = 0; n < 2; ++n)
#pragma unroll
                    for (int j = 0; j < 4; ++j) { const float g = acc[ai][0][m][n][j], uu = acc[ai][1][m][n][j];
                        const float s = __builtin_amdgcn_rcpf(1.0f + __builtin_amdgcn_exp2f(g * -1.4426950408889634f)); h[n * 4 + j] = g * s * uu; }
                u32x4 w; w.x = cvt_pk_bf16(h[0], h[1]); w.y = cvt_pk_bf16(h[2], h[3]); w.z = cvt_pk_bf16(h[4], h[5]); w.w = cvt_pk_bf16(h[6], h[7]);
                store16_wt(rowp, w); }
    }
};

struct CvtItem { const float* W; bf16* WT; int K, N, k0, n0, dr; };
__device__ __forceinline__ void cvt_load(const CvtItem& c, f32x4 (&v)[4], int tid) {
    const int lr = tid >> 5, lc = (tid & 31) * 4;
#pragma unroll
    for (int i = 0; i < 4; ++i) v[i] = *(const f32x4*)(c.W + (size_t)(c.k0 + lr + 16 * i) * c.N + c.n0 + lc);
}
__device__ __forceinline__ void cvt_to_lds(const f32x4 (&v)[4], LAS float* scr, int tid) {
    const int lr = tid >> 5, lc = (tid & 31) * 4;
#pragma unroll
    for (int i = 0; i < 4; ++i) { LAS float* d = scr + (lr + 16 * i) * 129 + lc; d[0] = v[i].x; d[1] = v[i].y; d[2] = v[i].z; d[3] = v[i].w; }
}
__device__ __forceinline__ void cvt_store(const CvtItem& c, const LAS float* scr, int tid) {
    const int cc = tid & 7;
#pragma unroll
    for (int j = 0; j < 2; ++j) { const int n = (tid >> 3) + 64 * j; const LAS float* s = scr + (8 * cc) * 129 + n;
        v4u o; o.x = pk2(s[0], s[129]); o.y = pk2(s[2 * 129], s[3 * 129]); o.z = pk2(s[4 * 129], s[5 * 129]); o.w = pk2(s[6 * 129], s[7 * 129]);
        store16_wt(c.WT + (size_t)(c.dr + n) * c.K + c.k0 + 8 * cc, o); }
}
__device__ __forceinline__ void convert_small(const Args& a, int l, int r, int lane) {
    constexpr int I_PAD = 128, I_SP = 192;
    bf16* Wb = (bf16*)(a.ws + WS_W);
    if (r < I_PAD) { v4u z = (v4u){0u, 0u, 0u, 0u}; v4u* p = (v4u*)(Wb + WOFF_IN + (size_t)(INW + r) * DM) + lane * 2; store16_wt(p, z); store16_wt(p + 1, z); return; } r -= I_PAD;
    if (r < I_SP) { const int idx = (r * 64 + lane) * 8, tt = (idx >> 7) & 127, s0 = idx & 127;
        const f32x4* src = (const f32x4*)(a.w_spatial + (size_t)l * 6 * CHUNK * CHUNK + idx); const f32x4 x0 = src[0], x1 = src[1];
        float f[8] = {x0.x, x0.y, x0.z, x0.w, x1.x, x1.y, x1.z, x1.w};
#pragma unroll
        for (int j = 0; j < 8; ++j) f[j] = (s0 + j <= tt) ? f[j] : 0.f;
        v4u o; o.x = pk2(f[0], f[1]); o.y = pk2(f[2], f[3]); o.z = pk2(f[4], f[5]); o.w = pk2(f[6], f[7]);
        store16_wt((bf16*)(a.ws + WS_SP) + idx, o); return; } r -= I_SP;
    { const int i8 = r * 64 + lane, gg = i8 >> 9, dd = (i8 >> 3) & 63, c0 = (i8 & 7) * 8;
        const float* src = a.w_pool + ((size_t)(l * 4 + gg) * 64 + c0) * 64 + dd;
        v4u o; o.x = pk2(src[0], src[64]); o.y = pk2(src[128], src[192]); o.z = pk2(src[256], src[320]); o.w = pk2(src[384], src[448]);
        store16_wt((bf16*)(a.ws + WS_PT) + (size_t)(gg * 64 + dd) * 64 + c0, o); }
}
__device__ __forceinline__ bool cvt_decode(const Args& a, int lA, int lB, int set, int it, CvtItem& c) {
    bf16* Wb = (bf16*)(a.ws + WS_W);
    if (set & 1) {
        if (it < 272) { const int kb = it / 17, nb = it % 17, n0 = 128 * nb; c = CvtItem{a.w_in + (size_t)lA * DM * INW, Wb + WOFF_IN, DM, INW, 64 * kb, n0, n0 < 1408 ? n0 + 768 : n0 - 1408}; return true; }
        if (it < 400) { const int r = it - 272, kb = r / 8, nb = r % 8; c = CvtItem{a.w_o + (size_t)lA * DM * DM, Wb + WOFF_O, DM, DM, 64 * kb, 128 * nb, 128 * nb}; return true; }
        it -= 400;
    }
    if (set & 2) {
        if (it < 704) { const int kb = it / 44, nb = it % 44; c = CvtItem{a.w_gate_up + (size_t)lB * DM * 2 * DFF, Wb + WOFF_GU, DM, 2 * DFF, 64 * kb, 128 * nb, nb < 22 ? 256 * nb : 256 * (nb - 22) + 128}; return true; }
        it -= 704;
    }
    if (set & 4) {
        if (it < 352) { const int kb = it / 8, nb = it % 8; c = CvtItem{a.w_down + (size_t)lB * DFF * DM, Wb + WOFF_DN, DFF, DM, 64 * kb, 128 * nb, 128 * nb}; return true; }
    }
    return false;
}
__device__ __forceinline__ void convert_set(const Args& a, int lA, int lB, int set, int idx, int n, LAS unsigned char* lds) {
    const int tid = fresh_tid(), lane = tid & 63, wave = __builtin_amdgcn_readfirstlane(tid >> 6);
    if (set & 1) for (int w = idx * NWAVES + wave; w < 352; w += n * NWAVES) convert_small(a, lA, w, lane);
    CvtItem c, cn; f32x4 v[4], vn[4];
    int it = idx, buf = 0;
    bool have = cvt_decode(a, lA, lB, set, it, c);
    if (have) cvt_load(c, v, tid);
    while (have) {
        LAS float* scr = (LAS float*)lds + buf * 8320;
        cvt_to_lds(v, scr, tid);
        it += n; const bool hn = cvt_decode(a, lA, lB, set, it, cn);
        if (hn) cvt_load(cn, vn, tid);
        __syncthreads();
        cvt_store(c, scr, tid);
        c = cn; have = hn; buf ^= 1;
#pragma unroll
        for (int i = 0; i < 4; ++i) v[i] = vn[i];
    }
}

__device__ __forceinline__ void ln_rows(const float* Y, const float* g, const float* b, float* of, bf16* ob, int G, int bx) {
    const int tid = fresh_tid(), lane = tid & 63, wave = __builtin_amdgcn_readfirstlane(tid >> 6), gw = bx * NWAVES + wave, NGW = G * NWAVES;
    f32x4 gv[4], bv[4];
#pragma unroll
    for (int j = 0; j < 4; ++j) { gv[j] = ((const f32x4*)g)[lane + 64 * j]; bv[j] = ((const f32x4*)b)[lane + 64 * j]; }
    for (int m = gw; m < M; m += NGW) {
        const f32x4* xr = (const f32x4*)(Y + (size_t)m * DM) + lane;
        f32x4 v[4]; float s = 0.f;
#pragma unroll
        for (int j = 0; j < 4; ++j) { v[j] = xr[64 * j]; s += (v[j].x + v[j].y) + (v[j].z + v[j].w); }
        const float mean = wave_sum(s) * (1.f / DM); float s2 = 0.f;
#pragma unroll
        for (int j = 0; j < 4; ++j) { v[j] = v[j] - mean; s2 += (v[j].x * v[j].x + v[j].y * v[j].y) + (v[j].z * v[j].z + v[j].w * v[j].w); }
        const float rstd = 1.f / sqrtf(wave_sum(s2) * (1.f / DM) + LN_EPS);
        f32x4* o4 = (f32x4*)(of + (size_t)m * DM) + lane;
        unsigned long long* o8 = (unsigned long long*)(ob + (size_t)m * DM) + lane;
#pragma unroll
        for (int j = 0; j < 4; ++j) { const f32x4 o = v[j] * rstd * gv[j] + bv[j]; o4[64 * j] = o;
            o8[64 * j] = (unsigned long long)pk2(o.x, o.y) | ((unsigned long long)pk2(o.z, o.w) << 32); }
    }
}
__device__ __forceinline__ void cvt_rows(const float* X, bf16* ob, int G, int bx) {
    const int tid = fresh_tid(), lane = tid & 63, wave = __builtin_amdgcn_readfirstlane(tid >> 6);
    const size_t np = (size_t)M * DM / 8, nw = (size_t)G * NWAVES, w = (size_t)bx * NWAVES + wave;
    for (size_t i0 = w * 64 + lane; i0 < np; i0 += 4 * nw * 64) {
        f32x4 v[4][2];
#pragma unroll
        for (int k = 0; k < 4; ++k) { const size_t i = i0 + (size_t)k * nw * 64; if (i < np) { v[k][0] = ((const f32x4*)X)[2 * i]; v[k][1] = ((const f32x4*)X)[2 * i + 1]; } }
#pragma unroll
        for (int k = 0; k < 4; ++k) { const size_t i = i0 + (size_t)k * nw * 64; if (i < np) { v4u o; o.x = pk2(v[k][0].x, v[k][0].y); o.y = pk2(v[k][0].z, v[k][0].w); o.z = pk2(v[k][1].x, v[k][1].y); o.w = pk2(v[k][1].z, v[k][1].w);
            store16_wt(ob + 8 * i, o); } }
    }
}

typedef short bf16x8v __attribute__((ext_vector_type(8)));
typedef unsigned v2u __attribute__((ext_vector_type(2)));
__device__ __forceinline__ void mix_sgu3(const Args& a, int l, int ck, int h0, LAS unsigned char* lds) {
    const int tid = fresh_tid(), lane = tid & 63, wave = __builtin_amdgcn_readfirstlane(tid >> 6);
    const bf16* P = (const bf16*)(a.ws + WS_R1); bf16* MX = (bf16*)(a.ws + WS_MIX);
    const int row0 = ck * CHUNK;
    const int s = tid >> 2, q = tid & 3;
    const int fr = lane & 15, fq = lane >> 4, nk = (wave >> 1) + 1, t = 16 * wave + fr;
    v4u vw[3][2];
#pragma unroll
    for (int hh = 0; hh < 3; ++hh) { const v4u* src = (const v4u*)(P + (size_t)(row0 + s) * PW + PC_V + 64 * (h0 + 2 * hh) + 16 * q); vw[hh][0] = src[0]; vw[hh][1] = src[1]; }
    bf16x8v bfrag[3][4]; v4u uu[3][2]; float bsp[3];
#pragma unroll
    for (int hh = 0; hh < 3; ++hh) { const int h = h0 + 2 * hh;
        const bf16* wrow = (const bf16*)(a.ws + WS_SP) + (size_t)h * CHUNK * CHUNK + (size_t)t * CHUNK + 8 * fq;
#pragma unroll
        for (int kk = 0; kk < 4; ++kk) { bfrag[hh][kk] = (bf16x8v){0, 0, 0, 0, 0, 0, 0, 0}; if (kk < nk) bfrag[hh][kk] = *(const bf16x8v*)(wrow + 32 * kk); }
#pragma unroll
        for (int pp = 0; pp < 2; ++pp) uu[hh][pp] = *(const v4u*)(P + (size_t)(row0 + t) * PW + PC_U + 64 * h + 32 * pp + 8 * fq);
        bsp[hh] = a.b_spatial[(size_t)(l * 6 + h) * CHUNK + t]; }
#pragma unroll
    for (int hh = 0; hh < 3; ++hh) {
        const int h = h0 + 2 * hh; LAS bf16* vt = (LAS bf16*)lds + hh * (64 * 136);
        float f[16]; UNPACK8(vw[hh][0], f, 0); UNPACK8(vw[hh][1], f, 8);
        float sm = 0.f;
#pragma unroll
        for (int j = 0; j < 16; ++j) sm += f[j];
        sm += __shfl_xor(sm, 1); sm += __shfl_xor(sm, 2);
        const float mean = sm * (1.f / 64.f); float s2 = 0.f;
#pragma unroll
        for (int j = 0; j < 16; ++j) { f[j] -= mean; s2 += f[j] * f[j]; }
        s2 += __shfl_xor(s2, 1); s2 += __shfl_xor(s2, 2);
        const float rstd = 1.f / sqrtf(s2 * (1.f / 64.f) + LN_EPS);
        const f32x4* gp = (const f32x4*)(a.sgu_ln_g + (size_t)l * SW + 64 * h + 16 * q);
#pragma unroll
        for (int j4 = 0; j4 < 4; ++j4) { const f32x4 gv = gp[j4];
            vt[(16 * q + 4 * j4 + 0) * 136 + s] = (bf16)f2bf(f[4 * j4] * rstd * gv.x); vt[(16 * q + 4 * j4 + 1) * 136 + s] = (bf16)f2bf(f[4 * j4 + 1] * rstd * gv.y);
            vt[(16 * q + 4 * j4 + 2) * 136 + s] = (bf16)f2bf(f[4 * j4 + 2] * rstd * gv.z); vt[(16 * q + 4 * j4 + 3) * 136 + s] = (bf16)f2bf(f[4 * j4 + 3] * rstd * gv.w); }
    }
    __syncthreads();
#pragma unroll
    for (int hh = 0; hh < 3; ++hh) { const int h = h0 + 2 * hh; const LAS bf16* vt = (const LAS bf16*)lds + hh * (64 * 136);
        f32x4 acc[4];
#pragma unroll
        for (int mt = 0; mt < 4; ++mt) acc[mt] = (f32x4){0.f, 0.f, 0.f, 0.f};
#pragma unroll
        for (int kk = 0; kk < 4; ++kk) {
            if (kk < nk) {
#pragma unroll
                for (int mt = 0; mt < 4; ++mt) { const int drow = 32 * (mt >> 1) + 8 * (fr >> 2) + 4 * (mt & 1) + (fr & 3);
                    const bf16x8v afrag = *(const LAS bf16x8v*)(vt + drow * 136 + 32 * kk + 8 * fq);
                    acc[mt] = __builtin_amdgcn_mfma_f32_16x16x32_bf16(afrag, bfrag[hh][kk], acc[mt], 0, 0, 0); }
            }
        }
#pragma unroll
        for (int pp = 0; pp < 2; ++pp) { const float bb = bsp[hh]; const v4u uw = uu[hh][pp]; pg8::u32x4 o;
            o.x = pk2(bflo(uw.x) * (acc[2 * pp][0] + bb), bfhi(uw.x) * (acc[2 * pp][1] + bb)); o.y = pk2(bflo(uw.y) * (acc[2 * pp][2] + bb), bfhi(uw.y) * (acc[2 * pp][3] + bb));
            o.z = pk2(bflo(uw.z) * (acc[2 * pp + 1][0] + bb), bfhi(uw.z) * (acc[2 * pp + 1][1] + bb)); o.w = pk2(bflo(uw.w) * (acc[2 * pp + 1][2] + bb), bfhi(uw.w) * (acc[2 * pp + 1][3] + bb));
            store16_wt(MX + (size_t)(row0 + t) * DM + 640 + 64 * h + 32 * pp + 8 * fq, o); }
    }
}
template <int WIN> __device__ __forceinline__ void pool_window(const bf16* Pg, int row0, bool first, int tb, LAS bf16* dt, int tid) {
    const int t0 = (tid >> 3) * 2, cg = tid & 7;
    const bf16* base = Pg + (size_t)row0 * PW + 8 * cg;
    float acc[8], pf[8], p0[8], p1[8];
#pragma unroll
    for (int j = 0; j < 8; ++j) { acc[j] = 0.f; pf[j] = 0.f; p0[j] = 0.f; p1[j] = 0.f; }
#pragma unroll
    for (int j = 0; j <= WIN; ++j) {
        const int rr = t0 - WIN + 1 + j; const bool valid = !first || rr >= 0;
        v4u w = (v4u){0u, 0u, 0u, 0u};
        if (valid) w = *(const v4u*)(base + (long)rr * PW);
        float f[8]; UNPACK8(w, f, 0);
#pragma unroll
        for (int c = 0; c < 8; ++c) { if (j == 0) pf[c] = f[c]; if (j < WIN) acc[c] += f[c]; if (j == WIN - 1) p0[c] = f[c]; if (j == WIN) p1[c] = f[c]; }
    }
    const int c0 = (tb + t0 + 1) < WIN ? (tb + t0 + 1) : WIN, c1 = (tb + t0 + 2) < WIN ? (tb + t0 + 2) : WIN;
    const float r0 = 1.f / (float)c0, r1 = 1.f / (float)c1;
    float d0[8], d1[8];
#pragma unroll
    for (int c = 0; c < 8; ++c) { d0[c] = acc[c] * r0 - p0[c]; d1[c] = (acc[c] + p1[c] - pf[c]) * r1 - p1[c]; }
    v4u o0, o1;
    o0.x = pk2(d0[0], d0[1]); o0.y = pk2(d0[2], d0[3]); o0.z = pk2(d0[4], d0[5]); o0.w = pk2(d0[6], d0[7]);
    o1.x = pk2(d1[0], d1[1]); o1.y = pk2(d1[2], d1[3]); o1.z = pk2(d1[4], d1[5]); o1.w = pk2(d1[6], d1[7]);
    *(LAS v4u*)(dt + t0 * 72 + 8 * cg) = o0; *(LAS v4u*)(dt + (t0 + 1) * 72 + 8 * cg) = o1;
}
template <int W0, int W1> __device__ __forceinline__ void mix_pool2(const Args& a, int l, int ck, int g0, LAS unsigned char* lds) {
    const int tid = fresh_tid(), lane = tid & 63, wave = __builtin_amdgcn_readfirstlane(tid >> 6);
    const bf16* P = (const bf16*)(a.ws + WS_R1); bf16* MX = (bf16*)(a.ws + WS_MIX);
    const int row0 = ck * CHUNK; const bool first = (ck % (SEQ / CHUNK)) == 0; const int tb = (ck % (SEQ / CHUNK)) * CHUNK;
    const int fr = lane & 15, fq = lane >> 4, t = 16 * wave + fr;
    bf16x8v afrag[2][2][4]; f32x4 ps[2][2][2];
#pragma unroll
    for (int gg = 0; gg < 2; ++gg) { const int g = g0 + 2 * gg; const bf16* WpT = (const bf16*)(a.ws + WS_PT) + (size_t)g * 64 * 64;
#pragma unroll
        for (int kk = 0; kk < 2; ++kk)
#pragma unroll
            for (int mt = 0; mt < 4; ++mt) { const int drow = 32 * (mt >> 1) + 8 * (fr >> 2) + 4 * (mt & 1) + (fr & 3); afrag[gg][kk][mt] = *(const bf16x8v*)(WpT + drow * 64 + 32 * kk + 8 * fq); }
#pragma unroll
        for (int pp = 0; pp < 2; ++pp) { ps[gg][pp][0] = *(const f32x4*)(a.pool_scale + (size_t)l * PWID + 64 * g + 32 * pp + 8 * fq); ps[gg][pp][1] = *(const f32x4*)(a.pool_scale + (size_t)l * PWID + 64 * g + 32 * pp + 8 * fq + 4); } }
    LAS bf16* dt0 = (LAS bf16*)lds; LAS bf16* dt1 = dt0 + 128 * 72;
    pool_window<W0>(P + PC_P + 64 * g0, row0, first, tb, dt0, tid);
    pool_window<W1>(P + PC_P + 64 * (g0 + 2), row0, first, tb, dt1, tid);
    __syncthreads();
#pragma unroll
    for (int gg = 0; gg < 2; ++gg) { const int g = g0 + 2 * gg; const LAS bf16* dt = gg ? dt1 : dt0;
        f32x4 acc[4];
#pragma unroll
        for (int mt = 0; mt < 4; ++mt) acc[mt] = (f32x4){0.f, 0.f, 0.f, 0.f};
#pragma unroll
        for (int kk = 0; kk < 2; ++kk) { const bf16x8v bfrag = *(const LAS bf16x8v*)(dt + t * 72 + 32 * kk + 8 * fq);
#pragma unroll
            for (int mt = 0; mt < 4; ++mt) acc[mt] = __builtin_amdgcn_mfma_f32_16x16x32_bf16(afrag[gg][kk][mt], bfrag, acc[mt], 0, 0, 0); }
#pragma unroll
        for (int pp = 0; pp < 2; ++pp) { pg8::u32x4 o; const f32x4 s0 = ps[gg][pp][0], s1 = ps[gg][pp][1];
            o.x = pk2(acc[2 * pp][0] * s0.x, acc[2 * pp][1] * s0.y); o.y = pk2(acc[2 * pp][2] * s0.z, acc[2 * pp][3] * s0.w);
            o.z = pk2(acc[2 * pp + 1][0] * s1.x, acc[2 * pp + 1][1] * s1.y); o.w = pk2(acc[2 * pp + 1][2] * s1.z, acc[2 * pp + 1][3] * s1.w);
            store16_wt(MX + (size_t)(row0 + t) * DM + 384 + 64 * g + 32 * pp + 8 * fq, o); }
    }
}
__device__ __forceinline__ void mix_conv(const Args& a, int l, int ck, int hc) {
    const int tid = fresh_tid();
    const bf16* P = (const bf16*)(a.ws + WS_R1); bf16* MX = (bf16*)(a.ws + WS_MIX);
    const int row0 = ck * CHUNK; const bool first = (ck % (SEQ / CHUNK)) == 0;
    const int t = tid >> 2, q = tid & 3, cb = 64 * hc + 16 * q;
    const float* wc = a.w_conv + (size_t)l * 3 * CW + cb;
    float y[16];
#pragma unroll
    for (int j = 0; j < 16; ++j) y[j] = 0.f;
#pragma unroll
    for (int k = 0; k < 3; ++k) {
        const int rr = t - 2 + k; const bool valid = !first || rr >= 0;
        v4u x0 = (v4u){0u, 0u, 0u, 0u}, x1 = x0, g0 = x0, g1 = x0;
        if (valid) { const v4u* sx = (const v4u*)(P + (size_t)(row0 + rr) * PW + PC_XA + cb); const v4u* sg = (const v4u*)(P + (size_t)(row0 + rr) * PW + PC_GC + cb); x0 = sx[0]; x1 = sx[1]; g0 = sg[0]; g1 = sg[1]; }
        float fx[16], fg[16]; UNPACK8(x0, fx, 0); UNPACK8(x1, fx, 8); UNPACK8(g0, fg, 0); UNPACK8(g1, fg, 8);
#pragma unroll
        for (int j4 = 0; j4 < 4; ++j4) { const f32x4 wv = *(const f32x4*)(wc + k * CW + 4 * j4);
            y[4 * j4] += wv.x * fx[4 * j4] * fg[4 * j4]; y[4 * j4 + 1] += wv.y * fx[4 * j4 + 1] * fg[4 * j4 + 1]; y[4 * j4 + 2] += wv.z * fx[4 * j4 + 2] * fg[4 * j4 + 2]; y[4 * j4 + 3] += wv.w * fx[4 * j4 + 3] * fg[4 * j4 + 3]; }
    }
    const v4u* sb = (const v4u*)(P + (size_t)(row0 + t) * PW + PC_GB + cb); const v4u b0 = sb[0], b1 = sb[1]; float fb[16]; UNPACK8(b0, fb, 0); UNPACK8(b1, fb, 8);
    v4u o0, o1;
    o0.x = pk2(fb[0] * y[0], fb[1] * y[1]); o0.y = pk2(fb[2] * y[2], fb[3] * y[3]); o0.z = pk2(fb[4] * y[4], fb[5] * y[5]); o0.w = pk2(fb[6] * y[6], fb[7] * y[7]);
    o1.x = pk2(fb[8] * y[8], fb[9] * y[9]); o1.y = pk2(fb[10] * y[10], fb[11] * y[11]); o1.z = pk2(fb[12] * y[12], fb[13] * y[13]); o1.w = pk2(fb[14] * y[14], fb[15] * y[15]);
    bf16* dst = MX + (size_t)(row0 + t) * DM + cb; store16_wt(dst, o0); store16_wt(dst + 8, o1);
}

#define XB_TMO      128
#define XB_XCNT(j)  (256  + 64 * (j))
#define XB_XSUB(j)  (1280 + 64 * (j))
#define XB_XGEN(j)  (2304 + 64 * (j))
#define XB_TOP      3328
#define XB_TOPGEN   3392
#define XCD_BAR_WORDS 3456
#define XB_SPIN_CAP (1u << 18)

__device__ __forceinline__ unsigned xb_ld(unsigned* p)              { return __hip_atomic_load(p, __ATOMIC_RELAXED, __HIP_MEMORY_SCOPE_AGENT); }
__device__ __forceinline__ unsigned xb_add(unsigned* p, unsigned v) { return __hip_atomic_fetch_add(p, v, __ATOMIC_RELAXED, __HIP_MEMORY_SCOPE_AGENT); }
__device__ __forceinline__ unsigned xb_xcc_id() { return (unsigned)__builtin_amdgcn_s_getreg((3 << 11) | 20) & 0xFu; }
#define XB_SPIN(cond, bar) do { unsigned _sp = 0; while (cond) { __builtin_amdgcn_s_sleep(1); \
    if ((++_sp & 255u) == 0u) { if (xb_ld(&(bar)[XB_TMO])) break; if (_sp > XB_SPIN_CAP) { atomicAdd(&(bar)[XB_TMO], 1u); break; } } } } while (0)

struct XcdBarrier {
    unsigned* bar; unsigned x;
    volatile LAS unsigned* st;
};

__device__ __forceinline__ XcdBarrier xcd_barrier_post(unsigned* bar, volatile LAS unsigned* st) {
    XcdBarrier b; b.bar = bar; b.x = xb_xcc_id(); b.st = st;
    if (threadIdx.x == 0) (void)xb_add(&bar[XB_XCNT(b.x)], 1u);
    return b;
}
__device__ __forceinline__ void xcd_barrier_complete(unsigned* bar, unsigned x, unsigned& nloc, unsigned& nx) {
    const unsigned G = gridDim.x * gridDim.y * gridDim.z;
    unsigned sum, cnt, mine, sp = 0u;
    for (;;) {
        sum = 0u; cnt = 0u; mine = 0u;
#pragma unroll
        for (unsigned j = 0; j < 16; ++j) { const unsigned c = xb_ld(&bar[XB_XCNT(j)]); sum += c; cnt += (c > 0u) ? 1u : 0u; mine = (j == x) ? c : mine; }
        if (sum == G) break;
        __builtin_amdgcn_s_sleep(1);
        if ((++sp & 255u) == 0u) { if (xb_ld(&bar[XB_TMO])) break; if (sp > XB_SPIN_CAP) { atomicAdd(&bar[XB_TMO], 1u); break; } }
    }
    nloc = mine > 0u ? mine : 1u; nx = cnt > 0u ? cnt : 1u;
}

__device__ __forceinline__ void xcd_barrier(const XcdBarrier& b) {
    asm volatile("s_waitcnt vmcnt(0)" ::: "memory");
    __syncthreads();
    if (threadIdx.x == 0) {
        unsigned* bar = b.bar;
        __builtin_amdgcn_s_waitcnt(0);
        unsigned nloc = b.st[0], nx = b.st[1];
        if (nloc == 0u) { xcd_barrier_complete(bar, b.x, nloc, nx); b.st[0] = nloc; b.st[1] = nx; }
        const unsigned old = xb_add(&bar[XB_XSUB(b.x)], 1u);
        const unsigned gen = old / nloc;
        if (old + 1u == (gen + 1u) * nloc) {
            __builtin_amdgcn_fence(__ATOMIC_RELEASE, "agent");
            asm volatile("s_waitcnt vmcnt(0)" ::: "memory");
            __builtin_amdgcn_fence(__ATOMIC_ACQUIRE, "agent");
            const unsigned og = xb_add(&bar[XB_TOP], 1u);
            const unsigned tg = og / nx;
            if (og + 1u == (tg + 1u) * nx) xb_add(&bar[XB_TOPGEN], 1u);
            else XB_SPIN(xb_ld(&bar[XB_TOPGEN]) == tg, bar);
            asm volatile("" ::: "memory");
            xb_add(&bar[XB_XGEN(b.x)], 1u);
            asm volatile("s_waitcnt vmcnt(0)" ::: "memory");
        } else {
            __builtin_amdgcn_fence(__ATOMIC_ACQUIRE, "agent");
            XB_SPIN(xb_ld(&bar[XB_XGEN(b.x)]) == gen, bar);
            asm volatile("" ::: "memory");
            asm volatile("s_waitcnt vmcnt(0)" ::: "memory");
        }
    }
    __syncthreads();
}

__global__ void __launch_bounds__(NTHR, 2) fwd_mega(Args a) {
    extern __shared__ __attribute__((aligned(16))) unsigned char lds_raw[];
    cg::grid_group grid = cg::this_grid();
    LAS unsigned char* lds = (LAS unsigned char*)lds_raw;
    const int G = gridDim.x, bx = blockIdx.x;
    volatile LAS unsigned* MISC = (volatile LAS unsigned*)(lds + 131072);
    if (threadIdx.x < 64) MISC[threadIdx.x] = 0u;
    __syncthreads();
    const XcdBarrier bar = xcd_barrier_post((unsigned*)(a.ws) + 4096, MISC + 8);
#define GRID_BAR() xcd_barrier(bar)
    bf16* Wb = (bf16*)(a.ws + WS_W); bf16* AB = (bf16*)(a.ws + WS_AB); bf16* MX = (bf16*)(a.ws + WS_MIX);
    float* Y = (float*)(a.ws + WS_Y); bf16* PR = (bf16*)(a.ws + WS_R1); bf16* HH = (bf16*)(a.ws + WS_R1);

    convert_set(a, 0, 0, 1, bx, G, lds);
    cvt_rows(a.x, AB, G, bx);
    if (a.ws == nullptr) grid.sync();
    GRID_BAR();

    for (int l = 0; l < DEPTH; ++l) {
        {   pg8::Gemm g{AB, Wb + WOFF_IN, M, PW, DM}; ProjOrder S; S.init(G, bx);
            EpiProj E{PR, PW, 3};
            pg8::gemm_phase<EpiProj, ProjOrder, true, true>(lds, g, S, E); }
        {   constexpr int NBUSY = (M / 256) * (PW / 256) % 256;
            if (bx >= NBUSY) convert_set(a, l, l, 2, bx - NBUSY, G - NBUSY, lds); }
        GRID_BAR();
        {   const int hsel = (bx >> 7) & 1, ck = bx & 127;
            mix_sgu3(a, l, ck, hsel, lds);
            if (hsel == 0) mix_pool2<2, 8>(a, l, ck, 0, lds + 65536); else mix_pool2<4, 16>(a, l, ck, 1, lds + 65536);
            mix_conv(a, l, ck, hsel); mix_conv(a, l, ck, hsel + 2); mix_conv(a, l, ck, hsel + 4); }
        GRID_BAR();
        {   pg8::Gemm g{MX, Wb + WOFF_O, M, DM, DM}; pg8::StaticOrder S; S.init(M, DM, G, bx);
            PanelStats2 st{(unsigned long long*)(a.ws + WS_Y), DM / 256, LN_EPS, (unsigned)(2 * l + 1)};
            EpiResLn E{AB, nullptr, AB, a.ln1_g + (size_t)l * DM, a.ln1_b + (size_t)l * DM, DM, ALPHA, st};
            pg8::gemm_phase<EpiResLn, pg8::StaticOrder, false, true>(lds, g, S, E); }
        GRID_BAR();
        {   pg8::Gemm g{AB, Wb + WOFF_GU, M, 2 * DFF, DM}; pg8::StaticOrder S; S.init(M, 2 * DFF, G, bx);
            EpiSwiglu E{HH, DFF};
            pg8::gemm_phase<EpiSwiglu, pg8::StaticOrder, true, true>(lds, g, S, E); }
        {   constexpr int NBUSY = (M / 256) * (2 * DFF / 256) % 256;
            if (bx >= NBUSY) convert_set(a, l + 1, l, (l + 1 < DEPTH ? 1 : 0) | 4, bx - NBUSY, G - NBUSY, lds); }
        GRID_BAR();
        {   pg8::Gemm g{HH, Wb + WOFF_DN, M, DM, DFF}; pg8::StaticOrder S; S.init(M, DM, G, bx);
            PanelStats2 st{(unsigned long long*)(a.ws + WS_Y), DM / 256, LN_EPS, (unsigned)(2 * l + 2)};
            EpiResLn E{AB, l + 1 == DEPTH ? a.out : nullptr, AB, a.ln2_g + (size_t)l * DM, a.ln2_b + (size_t)l * DM, DM, ALPHA, st};
            pg8::gemm_phase<EpiResLn, pg8::StaticOrder, false, true>(lds, g, S, E); }
        if (l + 1 < DEPTH) GRID_BAR();
    }
}

extern "C" void kernel_launch(void* const* d_in, const int* in_sizes, int n_in, void* d_out, int out_size, void* d_ws, size_t ws_size, hipStream_t stream) {
    static int grid = 0;
    if (grid == 0) {
        if (n_in != 15 || ws_size < WS_END) { fprintf(stderr, "kernel_launch: unexpected n_in %d / ws %zu\n", n_in, ws_size); grid = -1; return; }
        int dev = 0, cus = 0, per_cu = 0;
        (void)hipGetDevice(&dev); (void)hipDeviceGetAttribute(&cus, hipDeviceAttributeMultiprocessorCount, dev);
        (void)hipFuncSetAttribute((const void*)fwd_mega, hipFuncAttributeMaxDynamicSharedMemorySize, LDS_BYTES);
        (void)hipOccupancyMaxActiveBlocksPerMultiprocessor(&per_cu, (const void*)fwd_mega, NTHR, LDS_BYTES);
        if (per_cu < 1) { fprintf(stderr, "kernel_launch: occupancy query says %d blocks per CU\n", per_cu); per_cu = 1; }
        (void)hipGetLastError();
        grid = cus;
    }
    if (grid < 0) return;
    (void)hipMemsetAsync(d_ws, 0, 65536, stream);
    Args a{};
    a.x = (const float*)d_in[0]; a.w_in = (const float*)d_in[1]; a.w_conv = (const float*)d_in[2]; a.w_pool = (const float*)d_in[3]; a.pool_scale = (const float*)d_in[4];
    a.sgu_ln_g = (const float*)d_in[5]; a.w_spatial = (const float*)d_in[6]; a.b_spatial = (const float*)d_in[7]; a.w_o = (const float*)d_in[8];
    a.ln1_g = (const float*)d_in[9]; a.ln1_b = (const float*)d_in[10]; a.w_gate_up = (const float*)d_in[11]; a.w_down = (const float*)d_in[12];
    a.ln2_g = (const float*)d_in[13]; a.ln2_b = (const float*)d_in[14];
    a.out = (float*)d_out; a.ws = (unsigned char*)d_ws;
    void* args[] = {&a};
    hipError_t e = hipLaunchCooperativeKernel((const void*)fwd_mega, dim3(grid), dim3(NTHR), args, LDS_BYTES, stream);
    if (e != hipSuccess) fprintf(stderr, "cooperative launch failed: %s (grid %d)\n", hipGetErrorString(e), grid);
}
```
